# Optimizing an MI355X kernel written in HIP

```python
import jax, jax.numpy as jnp
from jax import lax
import numpy as np

D_MODEL = 2048
BATCH = 2
SEQ = 8192
DEPTH = 1

HEAD_DIM = 128
NSA_HEADS = 8
NSA_KV = 2
NSA_WIDTH = NSA_HEADS * HEAD_DIM
DSA_HEADS = 8
DSA_KV = 2
DSA_WIDTH = DSA_HEADS * HEAD_DIM
CMP_LEN = 32
CMP_STRIDE = 16
CMP_HIDDEN = 256
SEL_BLOCK = 64
SEL_TOPN = 16
WINDOW = 512
IDX_HEADS = 16
IDX_DIM = 64
DSA_TOPK_MAX = 256
PLE_DIM = 256
Q_BLOCK = 128
EPS = 1e-6
NEG = -1e30
FORCE_SCORE = 1e4

IN_SPLITS = (
    NSA_HEADS * HEAD_DIM,
    NSA_KV * HEAD_DIM,
    NSA_KV * HEAD_DIM,
    NSA_KV * HEAD_DIM,
    NSA_KV * HEAD_DIM,
    NSA_KV * HEAD_DIM,
    NSA_KV * HEAD_DIM,
    NSA_HEADS * 3,
    NSA_WIDTH,
    DSA_HEADS * HEAD_DIM,
    DSA_KV * HEAD_DIM,
    DSA_KV * HEAD_DIM,
    IDX_HEADS * IDX_DIM,
    IDX_DIM,
    IDX_HEADS,
    DSA_WIDTH,
    D_MODEL,
    D_MODEL,
)
IN_WIDTH = sum(IN_SPLITS)

kernel_name = "hybrid_nsa_dsa_gated_merge"


def _rms(x, g):
    xf = x.astype(jnp.float32)
    y = xf * lax.rsqrt(jnp.mean(xf * xf, axis=-1, keepdims=True) + EPS)
    return (y * g.astype(jnp.float32)).astype(x.dtype)


def _slopes(n):
    return 2.0 ** (-8.0 * jnp.arange(1, n + 1, dtype=jnp.float32) / n)


def _masked_softmax(s, mask):
    return jax.nn.softmax(jnp.where(mask, s, NEG), axis=-1)


def _compress(kv, pe, w1, w2):
    B, S, G, dh = kv.shape
    n_cmp = (S - CMP_LEN) // CMP_STRIDE + 1
    idx = jnp.arange(n_cmp)[:, None] * CMP_STRIDE + jnp.arange(CMP_LEN)[None, :]
    blk = kv[:, idx] + pe[None, None, :, None, :].astype(kv.dtype)
    blk = jnp.moveaxis(blk, 3, 2).reshape(B, n_cmp, G, CMP_LEN * dh)
    return jax.nn.silu(blk @ w1) @ w2


def _cmp_to_sel(n_cmp, n_sel):
    c0 = np.arange(n_cmp)[:, None] * CMP_STRIDE
    s0 = np.arange(n_sel)[None, :] * SEL_BLOCK
    ov = np.clip(np.minimum(c0 + CMP_LEN, s0 + SEL_BLOCK) - np.maximum(c0, s0), 0, None)
    return jnp.asarray(ov / CMP_LEN, dtype=jnp.float32)


def _nsa_mixer(q, kc, vc, ks, vs, kw, vw, gates):
    B, S, H, dh = q.shape
    G = ks.shape[2]
    Hg = H // G
    scale = dh ** -0.5
    slopes = _slopes(H).reshape(G, Hg)
    t = jnp.arange(S)
    qg = q.reshape(B, S, G, Hg, dh)

    n_cmp = kc.shape[1]
    c_end = jnp.arange(n_cmp) * CMP_STRIDE + CMP_LEN - 1
    c_mid = c_end.astype(jnp.float32) - (CMP_LEN - 1) / 2.0
    vis = c_end[None, :] <= t[:, None]
    s = jnp.einsum('btgjd,bngd->bgjtn', qg, kc).astype(jnp.float32) * scale
    s = s - slopes[:, :, None, None] * (t[:, None].astype(jnp.float32) - c_mid[None, :])
    p_cmp = _masked_softmax(s, vis) * (t >= CMP_LEN - 1)[:, None].astype(jnp.float32)
    o_cmp = jnp.einsum('bgjtn,bngd->btgjd', p_cmp.astype(vc.dtype), vc).reshape(B, S, H, dh)

    n_sel = S // SEL_BLOCK
    top_n = min(SEL_TOPN, n_sel)
    imp = jnp.einsum('bgtn,nm->btgm', p_cmp.sum(2), _cmp_to_sel(n_cmp, n_sel))
    m = jnp.arange(n_sel)[None, :]
    blk_t = (t // SEL_BLOCK)[:, None]
    valid = (m <= blk_t)[:, None, :]
    forced = ((m == 0) | (m == blk_t) | (m == blk_t - 1))[:, None, :]
    imp = jnp.where(valid & forced, FORCE_SCORE, jnp.where(valid, imp, -1.0))
    _, sel = lax.top_k(imp, top_n)

    ks_blk = jnp.moveaxis(ks.reshape(B, n_sel, SEL_BLOCK, G, dh), 3, 1).reshape(B, G, n_sel, SEL_BLOCK * dh)
    vs_blk = jnp.moveaxis(vs.reshape(B, n_sel, SEL_BLOCK, G, dh), 3, 1).reshape(B, G, n_sel, SEL_BLOCK * dh)
    kw_pad = jnp.pad(kw, ((0, 0), (WINDOW, 0), (0, 0), (0, 0)))
    vw_pad = jnp.pad(vw, ((0, 0), (WINDOW, 0), (0, 0), (0, 0)))
    n_keys = top_n * SEL_BLOCK

    def chunk(c):
        t0 = c * Q_BLOCK
        tq = t0 + jnp.arange(Q_BLOCK)
        qc = lax.dynamic_slice_in_dim(qg, t0, Q_BLOCK, axis=1)
        sc = jnp.moveaxis(lax.dynamic_slice_in_dim(sel, t0, Q_BLOCK, axis=1), 2, 1)
        idx = sc.reshape(B, G, Q_BLOCK * top_n, 1)
        kg = jnp.take_along_axis(ks_blk, idx, axis=2).reshape(B, G, Q_BLOCK, n_keys, dh)
        vg = jnp.take_along_axis(vs_blk, idx, axis=2).reshape(B, G, Q_BLOCK, n_keys, dh)
        kpos = (sc[..., None] * SEL_BLOCK + jnp.arange(SEL_BLOCK)).reshape(B, G, Q_BLOCK, n_keys)
        dist = (tq[:, None] - kpos).astype(jnp.float32)
        s1 = jnp.einsum('bqgjd,bgqkd->bgjqk', qc, kg).astype(jnp.float32) * scale
        s1 = s1 - slopes[None, :, :, None, None] * dist[:, :, None]
        p1 = _masked_softmax(s1, (dist >= 0)[:, :, None])
        o_slc = jnp.einsum('bgjqk,bgqkd->bqgjd', p1.astype(vg.dtype), vg)
        kwc = lax.dynamic_slice_in_dim(kw_pad, t0, WINDOW + Q_BLOCK, axis=1)
        vwc = lax.dynamic_slice_in_dim(vw_pad, t0, WINDOW + Q_BLOCK, axis=1)
        kpos_w = t0 - WINDOW + jnp.arange(WINDOW + Q_BLOCK)
        dw = tq[:, None] - kpos_w[None, :]
        mw = (dw >= 0) & (dw < WINDOW) & (kpos_w[None, :] >= 0)
        s2 = jnp.einsum('bqgjd,bkgd->bgjqk', qc, kwc).astype(jnp.float32) * scale
        s2 = s2 - slopes[:, :, None, None] * dw.astype(jnp.float32)
        p2 = _masked_softmax(s2, mw)
        o_win = jnp.einsum('bgjqk,bkgd->bqgjd', p2.astype(vwc.dtype), vwc)
        return o_slc, o_win

    o_slc, o_win = lax.map(chunk, jnp.arange(S // Q_BLOCK))
    o_slc = jnp.moveaxis(o_slc, 0, 1).reshape(B, S, H, dh)
    o_win = jnp.moveaxis(o_win, 0, 1).reshape(B, S, H, dh)
    g = jax.nn.sigmoid(gates)
    o = g[..., 0:1] * o_cmp + g[..., 1:2] * o_slc + g[..., 2:3] * o_win
    return o.reshape(B, S, H * dh)


def _dsa_mixer(q, k, v, qi, ki, wi):
    B, S, H, dh = q.shape
    G = k.shape[2]
    Hg = H // G
    scale = dh ** -0.5
    slopes = _slopes(H).reshape(G, Hg)
    topk = min(DSA_TOPK_MAX, S // 4)
    qg = q.reshape(B, S, G, Hg, dh)
    wi = wi.astype(jnp.float32) * IDX_HEADS ** -0.5
    s_all = jnp.arange(S)

    def chunk(c):
        t0 = c * Q_BLOCK
        tq = t0 + jnp.arange(Q_BLOCK)
        qic = lax.dynamic_slice_in_dim(qi, t0, Q_BLOCK, axis=1)
        wic = lax.dynamic_slice_in_dim(wi, t0, Q_BLOCK, axis=1)
        qc = lax.dynamic_slice_in_dim(qg, t0, Q_BLOCK, axis=1)
        rel = jax.nn.relu(jnp.einsum('bqhd,bsd->bqhs', qic, ki).astype(jnp.float32) * IDX_DIM ** -0.5)
        score = jnp.einsum('bqhs,bqh->bqs', rel, wic)
        score = jnp.where(s_all[None, :] <= tq[:, None], score, NEG)
        _, idx = lax.top_k(score, topk)
        kg = jax.vmap(lambda a, i: a[i])(k, idx)
        vg = jax.vmap(lambda a, i: a[i])(v, idx)
        dist = (tq[None, :, None] - idx).astype(jnp.float32)
        s = jnp.einsum('bqgjd,bqkgd->bgjqk', qc, kg).astype(jnp.float32) * scale
        s = s - slopes[:, :, None, None] * dist[:, None, None]
        pr = _masked_softmax(s, (dist >= 0)[:, None, None])
        return jnp.einsum('bgjqk,bqkgd->bqgjd', pr.astype(vg.dtype), vg)

    o = lax.map(chunk, jnp.arange(S // Q_BLOCK))
    return jnp.moveaxis(o, 0, 1).reshape(B, S, H * dh)


def setup_inputs(seed: int = 0) -> dict:
    key = jax.random.key(seed)
    ks = jax.random.split(key, 24)
    L = DEPTH

    def nrm(k, shape, scale):
        return jax.random.normal(k, shape, jnp.float32) * scale

    def gain(k, shape):
        return 1.0 + 0.01 * jax.random.normal(k, shape, jnp.float32)

    return {
        "x": nrm(ks[0], (BATCH, SEQ, D_MODEL), 1.0),
        "p": nrm(ks[1], (DEPTH, BATCH, SEQ, PLE_DIM), 1.0),
        "norm_g": gain(ks[2], (L, D_MODEL)),
        "w_in": nrm(ks[3], (L, D_MODEL, IN_WIDTH), D_MODEL ** -0.5),
        "nsa_q_g": gain(ks[4], (L, HEAD_DIM)),
        "nsa_kc_g": gain(ks[5], (L, HEAD_DIM)),
        "nsa_ks_g": gain(ks[6], (L, HEAD_DIM)),
        "nsa_kw_g": gain(ks[7], (L, HEAD_DIM)),
        "cmp_pe_k": nrm(ks[8], (L, CMP_LEN, HEAD_DIM), 0.1),
        "cmp_w1_k": nrm(ks[9], (L, CMP_LEN * HEAD_DIM, CMP_HIDDEN), (CMP_LEN * HEAD_DIM) ** -0.5),
        "cmp_w2_k": nrm(ks[10], (L, CMP_HIDDEN, HEAD_DIM), CMP_HIDDEN ** -0.5),
        "cmp_pe_v": nrm(ks[11], (L, CMP_LEN, HEAD_DIM), 0.1),
        "cmp_w1_v": nrm(ks[12], (L, CMP_LEN * HEAD_DIM, CMP_HIDDEN), (CMP_LEN * HEAD_DIM) ** -0.5),
        "cmp_w2_v": nrm(ks[13], (L, CMP_HIDDEN, HEAD_DIM), CMP_HIDDEN ** -0.5),
        "dsa_q_g": gain(ks[14], (L, HEAD_DIM)),
        "dsa_k_g": gain(ks[15], (L, HEAD_DIM)),
        "w_up_nsa": nrm(ks[16], (L, NSA_WIDTH, D_MODEL), NSA_WIDTH ** -0.5),
        "w_up_dsa": nrm(ks[17], (L, DSA_WIDTH, D_MODEL), DSA_WIDTH ** -0.5),
        "w_out": nrm(ks[18], (L, D_MODEL, D_MODEL), D_MODEL ** -0.5),
        "ple_norm_g": gain(ks[19], (L, D_MODEL)),
        "w_ple_gate": nrm(ks[20], (L, D_MODEL, D_MODEL), D_MODEL ** -0.5),
        "w_ple_proj": nrm(ks[21], (L, PLE_DIM, D_MODEL), PLE_DIM ** -0.5),
    }


def reference(x, p, norm_g, w_in, nsa_q_g, nsa_kc_g, nsa_ks_g, nsa_kw_g,
              cmp_pe_k, cmp_w1_k, cmp_w2_k, cmp_pe_v, cmp_w1_v, cmp_w2_v,
              dsa_q_g, dsa_k_g, w_up_nsa, w_up_dsa, w_out,
              ple_norm_g, w_ple_gate, w_ple_proj):
    B, S, _ = x.shape
    split_points = [int(v) for v in np.cumsum(IN_SPLITS)[:-1]]

    def heads(a):
        return a.reshape(B, S, -1, HEAD_DIM)

    for i in range(DEPTH):
        h = _rms(x, norm_g[i])
        proj = h @ w_in[i]
        (nq, nkc, nvc, nks, nvs, nkw, nvw, ng, nz,
         dq, dk, dv, iq, ik, iw, dz, mg_nsa, mg_dsa) = jnp.split(proj, split_points, axis=-1)

        q_n = _rms(heads(nq), nsa_q_g[i])
        kc = _rms(_compress(heads(nkc), cmp_pe_k[i], cmp_w1_k[i], cmp_w2_k[i]), nsa_kc_g[i])
        vc = _compress(heads(nvc), cmp_pe_v[i], cmp_w1_v[i], cmp_w2_v[i])
        o_nsa = _nsa_mixer(q_n, kc, vc,
                           _rms(heads(nks), nsa_ks_g[i]), heads(nvs),
                           _rms(heads(nkw), nsa_kw_g[i]), heads(nvw),
                           ng.reshape(B, S, NSA_HEADS, 3))
        o_nsa = o_nsa * jax.nn.silu(nz)

        o_dsa = _dsa_mixer(_rms(heads(dq), dsa_q_g[i]), _rms(heads(dk), dsa_k_g[i]), heads(dv),
                           iq.reshape(B, S, IDX_HEADS, IDX_DIM), ik, iw)
        o_dsa = o_dsa * jax.nn.silu(dz)

        y = jax.nn.sigmoid(mg_nsa) * (o_nsa @ w_up_nsa[i]) + jax.nn.sigmoid(mg_dsa) * (o_dsa @ w_up_dsa[i])
        x = x + y @ w_out[i]

        x = x + (p[i] @ w_ple_proj[i]) * jax.nn.sigmoid(_rms(x, ple_norm_g[i]) @ w_ple_gate[i])
    return x
```

```cpp
#ifndef DSA_BATCH
#define DSA_BATCH 2
#endif
#ifndef WGM_INPROJ
#define WGM_INPROJ 6
#endif
#ifndef WGM_OUT
#define WGM_OUT 2
#endif
#include <hip/hip_runtime.h>
#include <cstdio>
#include <cstdint>

#define LAS __attribute__((address_space(3)))
#define GAS __attribute__((address_space(1)))
typedef unsigned short bf16;
typedef short bf16x8 __attribute__((ext_vector_type(8)));
typedef float f32x4 __attribute__((ext_vector_type(4)));
typedef float f32x2 __attribute__((ext_vector_type(2)));
typedef float f32x16 __attribute__((ext_vector_type(16)));
typedef unsigned u32x4 __attribute__((ext_vector_type(4)));
typedef unsigned u32x2 __attribute__((ext_vector_type(2)));
typedef GAS unsigned gu32;

constexpr int NB = 2, S = 8192, T = NB * S, DM = 2048, HD = 128;
constexpr int NIN = 11368, NPAD = 11520;
constexpr float EPS = 1e-6f;
constexpr float LOG2E = 1.4426950408889634f;
constexpr float QSCALE = 0.08838834764831845f * LOG2E;
constexpr int NWAVES = 8, NTHR = 512;

constexpr size_t MiB = 1u << 20;
constexpr size_t WS_CTL = 0, CTL_ZERO_BYTES = 1 * MiB;
constexpr size_t WS_R0 = 1 * MiB;
constexpr size_t WS_BIASP = 1 * MiB + 65536;
constexpr size_t WS_BIAS = 1 * MiB + 65536 + 131072;
constexpr size_t WS_GN = 1 * MiB + 65536 + 131072 + 4096;
constexpr size_t WS_MISC = 2 * MiB;
constexpr size_t WS_IK = 5 * MiB;
constexpr size_t WS_KC = 7 * MiB, WS_VC = 7 * MiB + 524288;
constexpr size_t WS_WIN = 8 * MiB;
constexpr size_t WS_WUPN = 53 * MiB, WS_WUPD = 57 * MiB, WS_WOUT = 61 * MiB, WS_WG = 69 * MiB, WS_WPP = 77 * MiB, WS_WC1K = 78 * MiB, WS_WC1V = 80 * MiB;
constexpr size_t WS_PB = 84 * MiB;
constexpr size_t WS_XB = 92 * MiB;
constexpr size_t WS_QN = 156 * MiB, WS_NZ = 188 * MiB, WS_DQ = 220 * MiB, WS_IQ = 252 * MiB, WS_DZ = 284 * MiB;
constexpr size_t WS_X1B = WS_IQ;
constexpr size_t WS_KCR = 316 * MiB, WS_VCR = 324 * MiB, WS_KS = 332 * MiB, WS_VS = 340 * MiB, WS_KW = 348 * MiB, WS_VW = 356 * MiB, WS_DK = 364 * MiB, WS_DV = 372 * MiB;
constexpr size_t WS_PP = 380 * MiB;
constexpr size_t WS_QS = 444 * MiB;
constexpr size_t WS_GIDX = 453 * MiB;
constexpr size_t WS_CP4 = 461 * MiB;
constexpr size_t WS_END = 493 * MiB;
constexpr int CW_TMO = 0;
constexpr int CW_BAR = 4096;
constexpr int CW_Q0 = 8192;
constexpr size_t CTL_BIAS = 327680;
constexpr size_t CTL_SS1 = 262144;

__device__ __forceinline__ unsigned cvt_pk_bf16(float lo, float hi) { unsigned r; asm volatile("v_cvt_pk_bf16_f32 %0, %1, %2" : "=v"(r) : "v"(lo), "v"(hi)); return r; }
typedef _Float16 f16x2_t __attribute__((ext_vector_type(2)));
typedef _Float16 f16x8 __attribute__((ext_vector_type(8)));
__device__ __forceinline__ unsigned cvt_pk_f16(float lo, float hi) { const f16x2_t h = {(_Float16)lo, (_Float16)hi}; return __builtin_bit_cast(unsigned, h); }
__device__ __forceinline__ float bf_lo(unsigned w) { return __uint_as_float(w << 16); }
__device__ __forceinline__ float bf_hi(unsigned w) { return __uint_as_float(w & 0xffff0000u); }
__device__ __forceinline__ float sigmoidf_(float v) { return __builtin_amdgcn_rcpf(1.0f + __builtin_amdgcn_exp2f(-LOG2E * v)); }
__device__ __forceinline__ int sum8_dpp(int v) {
    v += __builtin_amdgcn_update_dpp(0, v, 0xB1, 0xF, 0xF, false);
    v += __builtin_amdgcn_update_dpp(0, v, 0x4E, 0xF, 0xF, false);
    v += __builtin_amdgcn_update_dpp(0, v, 0x141, 0xF, 0xF, false);
    return v;
}
__device__ __forceinline__ float wave_sum(float v) {
#pragma unroll
    for (int o = 1; o < 64; o <<= 1) v += __shfl_xor(v, o);
    return v;
}
__device__ __forceinline__ int lane_id() { int l; asm volatile("v_mbcnt_lo_u32_b32 %0, -1, 0\n\tv_mbcnt_hi_u32_b32 %0, -1, %0" : "=v"(l)); return l; }
#define LDS_WAIT() asm volatile("s_waitcnt lgkmcnt(0)" ::: "memory")
#define VM_WAIT() asm volatile("s_waitcnt vmcnt(0)" ::: "memory")

namespace pg8 {
constexpr int BM = 256, BK = 64, HALF = 128, HTB = HALF * BK * 2, STAGE_BYTES = 8 * HTB, NXCD = 8, WGM = 4;
__host__ __device__ __forceinline__ int lds_byte(int r, int c) { return r * 128 + ((c * 2) ^ ((r & 7) << 4)); }
__host__ __device__ __forceinline__ void stage_rc(int b, int& R, int& C) { R = b >> 7; C = ((b & 127) ^ ((R & 7) << 4)) >> 1; }
__host__ __device__ __forceinline__ int perm32(int rho) { const int n = rho >> 4, i = rho & 15; return 8 * (i >> 2) + 4 * n + (i & 3); }

struct Unit { int pm, pn, tag; const char* A; const char* B; };

struct TileOrder {
    int nM, nN, nwg, wgm;
    __device__ __forceinline__ void init(int nM_, int nN_, int wgm_ = WGM) { nM = nM_; nN = nN_; nwg = nM * nN; wgm = wgm_; }
    __device__ __forceinline__ void tile(int L, int& pm, int& pn) const {
        int wgid = L; { const int q = nwg / NXCD, r = nwg % NXCD, xcd = wgid % NXCD, off = wgid / NXCD; wgid = (xcd < r ? xcd * (q + 1) : r * (q + 1) + (xcd - r) * q) + off; }
        const int nig = wgm * nN, gid = wgid / nig, fm = gid * wgm, gsz = (nM - fm) < wgm ? (nM - fm) : wgm;
        pm = fm + ((wgid % nig) % gsz); pn = (wgid % nig) / gsz;
    }
};

template <int K, int lda, int ldb, class Epi, class Sched, bool HALFN = false>
__device__ __forceinline__ void gemm_phase(LAS unsigned char* lds, const int wid, const Sched& S, const Epi& E) {
    const int lane = lane_id(), tid = wid * 64 + lane, wr = wid >> 2, wc = wid & 3, fr = lane & 15, fq = lane >> 4;
    const int nt = K / BK;
    unsigned voffA, voffB;
    { int R, C; stage_rc(tid * 16, R, C); const int Rb = (R & ~31) + perm32(R & 31);
      voffA = (unsigned)(R * lda + C) * 2u; voffB = (unsigned)(Rb * ldb + C) * 2u; }
    constexpr size_t pstepA = (size_t)64 * lda * 2, pstepB = (size_t)64 * ldb * 2;
    const size_t kstep = (size_t)(BK * 2);
    const size_t hstepA = (size_t)HALF * lda * 2, hstepB = (size_t)HALF * ldb * 2;
    const unsigned ldsw = (unsigned)wid * 1024u;
    const int aoff = lds_byte(wr * 64 + fr, fq * 8), boff = lds_byte(wc * 32 + fr, fq * 8), aoff1 = aoff ^ 64, boff1 = boff ^ 64;
#define PG8_SA(b, h) (((b) * 2 + (h)) * HTB)
#define PG8_SB(b, h) ((4 + (b) * 2 + (h)) * HTB)
#define PG8_STAGE(bufoff, gbase, voff) do { const char* g1_ = (const char*)(gbase); const char* g2_ = g1_ + pstep_##voff; asm volatile("" : "+s"(g1_), "+s"(g2_)); \
        __builtin_amdgcn_global_load_lds((const unsigned*)(g1_ + (voff)), (LAS unsigned*)(lds + (bufoff) + ldsw), 16, 0, 0); \
        __builtin_amdgcn_global_load_lds((const unsigned*)(g2_ + (voff)), (LAS unsigned*)(lds + (bufoff) + ldsw + 8192), 16, 0, 0); } while (0)
#define pstep_voffA pstepA
#define pstep_voffB pstepB
#define PG8_LDA(dst, b, h) do { _Pragma("unroll") for (int m = 0; m < 4; ++m) _Pragma("unroll") for (int k = 0; k < 2; ++k) dst[m][k] = *(const LAS bf16x8*)(lds + PG8_SA(b, h) + (k ? aoff1 : aoff) + m * 2048); } while (0)
#define PG8_LDB(dst, b, h) do { _Pragma("unroll") for (int n = 0; n < 2; ++n) _Pragma("unroll") for (int k = 0; k < 2; ++k) dst[n][k] = *(const LAS bf16x8*)(lds + PG8_SB(b, h) + (k ? boff1 : boff) + n * 2048); } while (0)
#define PG8_MMA(ai, bj, At, Bt) do { __builtin_amdgcn_s_setprio(1); _Pragma("unroll") for (int m = 0; m < 4; ++m) _Pragma("unroll") for (int n = 0; n < 2; ++n) _Pragma("unroll") for (int k = 0; k < 2; ++k) \
        acc[ai][bj][m][n] = __builtin_amdgcn_mfma_f32_16x16x32_bf16(Bt[n][k], At[m][k], acc[ai][bj][m][n], 0, 0, 0); __builtin_amdgcn_s_setprio(0); } while (0)
#define PG8_LDB1(dst, b, h) do { if constexpr (!HALFN) PG8_LDB(dst, b, h); } while (0)
#define PG8_MMA1(ai, At, Bt) do { if constexpr (!HALFN) PG8_MMA(ai, 1, At, Bt); } while (0)
#define PG8_WAIT_V(n) asm volatile("s_waitcnt vmcnt(" #n ")" ::: "memory")
#define PG8_WAIT_L(n) asm volatile("s_waitcnt lgkmcnt(" #n ")" ::: "memory")
#define PG8_BAR __builtin_amdgcn_s_barrier()
#define PG8_SCHED __builtin_amdgcn_sched_barrier(0)
    Unit cur, nxt; int ui = 0;
    if (!S.next(0, cur)) return;
    f32x4 acc[2][2][4][2];
#pragma unroll
    for (int a = 0; a < 2; ++a)
#pragma unroll
        for (int b = 0; b < 2; ++b)
#pragma unroll
            for (int m = 0; m < 4; ++m)
#pragma unroll
                for (int n = 0; n < 2; ++n) acc[a][b][m][n] = (f32x4){0.f, 0.f, 0.f, 0.f};
    bf16x8 At[4][2], B0[2][2], B1[2][2];
    const char* cA = cur.A; const char* cB = cur.B;
    PG8_STAGE(PG8_SB(0, 0), cB, voffB); PG8_STAGE(PG8_SB(0, 1), cB + hstepB, voffB); PG8_STAGE(PG8_SA(0, 0), cA, voffA); PG8_STAGE(PG8_SA(0, 1), cA + hstepA, voffA);
    if (wr == 1) PG8_BAR;
    PG8_WAIT_V(2); PG8_BAR;
    PG8_STAGE(PG8_SB(1, 0), cB + kstep, voffB); PG8_STAGE(PG8_SA(1, 0), cA + kstep, voffA); PG8_STAGE(PG8_SB(1, 1), cB + hstepB + kstep, voffB);
    PG8_WAIT_V(6); PG8_BAR;
    for (;;) {
        const bool has_next = S.next(ui + 1, nxt);
        const char* nA = has_next ? nxt.A : cA; const char* nB = has_next ? nxt.B : cB;
        for (int t = 0; t < nt; t += 2) {
            const bool last = (t == nt - 2);
            const char* a1 = cA + (size_t)(t + 1) * kstep;
            const char* a2 = last ? nA : cA + (size_t)(t + 2) * kstep; const char* b2 = last ? nB : cB + (size_t)(t + 2) * kstep;
            const char* a3 = a2 + kstep; const char* b3 = b2 + kstep;
            PG8_LDB(B0, 0, 0); PG8_LDB1(B1, 0, 1); PG8_SCHED; PG8_LDA(At, 0, 0); PG8_STAGE(PG8_SA(1, 1), a1 + hstepA, voffA);
            PG8_WAIT_V(8); PG8_WAIT_L(0); PG8_BAR; PG8_MMA(0, 0, At, B0); PG8_MMA1(0, At, B1); PG8_BAR; PG8_SCHED;
            PG8_LDA(At, 0, 1); PG8_STAGE(PG8_SB(0, 0), b2, voffB); PG8_STAGE(PG8_SB(0, 1), b2 + hstepB, voffB); PG8_STAGE(PG8_SA(0, 0), a2, voffA);
            PG8_WAIT_V(8); PG8_WAIT_L(0); PG8_BAR; PG8_MMA(1, 0, At, B0); PG8_MMA1(1, At, B1); PG8_BAR; PG8_SCHED;
            PG8_LDB(B0, 1, 0); PG8_LDB1(B1, 1, 1); PG8_SCHED; PG8_LDA(At, 1, 0); PG8_STAGE(PG8_SA(0, 1), a2 + hstepA, voffA);
            PG8_WAIT_V(8); PG8_WAIT_L(0); PG8_BAR; PG8_MMA(0, 0, At, B0); PG8_MMA1(0, At, B1); PG8_BAR; PG8_SCHED;
            PG8_LDA(At, 1, 1); PG8_STAGE(PG8_SB(1, 0), b3, voffB); PG8_STAGE(PG8_SB(1, 1), b3 + hstepB, voffB); PG8_STAGE(PG8_SA(1, 0), a3, voffA);
            PG8_WAIT_V(8); PG8_WAIT_L(0); PG8_BAR; PG8_MMA(1, 0, At, B0); PG8_MMA1(1, At, B1); PG8_BAR; PG8_SCHED;
        }
        if (wr == 0) PG8_BAR;
        int lane_e = lane_id(); asm volatile("" : "+v"(lane_e));
        int wid_e = wid; asm volatile("" : "+s"(wid_e));
        const bool keep = E(acc, cur, wid_e >> 2, wid_e & 3, lane_e & 15, lane_e >> 4);
        __builtin_amdgcn_s_waitcnt(0x0F70);
        if (!has_next) break;
        if (!keep) {
#pragma unroll
            for (int a = 0; a < 2; ++a)
#pragma unroll
                for (int b = 0; b < 2; ++b)
#pragma unroll
                    for (int m = 0; m < 4; ++m)
#pragma unroll
                        for (int n = 0; n < 2; ++n) acc[a][b][m][n] = (f32x4){0.f, 0.f, 0.f, 0.f};
        }
        cur = nxt; cA = nA; cB = nB; ++ui;
        if (wr == 1) PG8_BAR;
    }
    PG8_WAIT_V(0);
    PG8_BAR;
#undef PG8_SA
#undef PG8_SB
#undef PG8_STAGE
#undef pstep_voffA
#undef pstep_voffB
#undef PG8_LDA
#undef PG8_LDB
#undef PG8_LDB1
#undef PG8_MMA1
#undef PG8_MMA
#undef PG8_WAIT_V
#undef PG8_WAIT_L
#undef PG8_BAR
#undef PG8_SCHED
}
}

#define XB_TMO      128
#define XB_XCNT(j)  (256  + 64 * (j))
#define XB_XSUB(j)  (1280 + 64 * (j))
#define XB_XGEN(j)  (2304 + 64 * (j))
#define XB_TOP      3328
#define XB_TOPGEN   3392
#define XCD_BAR_WORDS 3456
#define XB_SPIN_CAP (1u << 22)
__device__ __forceinline__ unsigned xb_ld(unsigned* p)              { return __hip_atomic_load(p, __ATOMIC_RELAXED, __HIP_MEMORY_SCOPE_AGENT); }
__device__ __forceinline__ unsigned xb_add(unsigned* p, unsigned v) { return __hip_atomic_fetch_add(p, v, __ATOMIC_RELAXED, __HIP_MEMORY_SCOPE_AGENT); }
__device__ __forceinline__ unsigned xb_xcc_id() { return (unsigned)__builtin_amdgcn_s_getreg((3 << 11) | 20) & 0xFu; }
#define XB_SPIN(cond, bar) do { unsigned _sp = 0; while (cond) { __builtin_amdgcn_s_sleep(1); \
    if ((++_sp & 255u) == 0u) { if (xb_ld(&(bar)[XB_TMO])) break; if (_sp > XB_SPIN_CAP) { atomicAdd(&(bar)[XB_TMO], 1u); break; } } } } while (0)
struct XcdBarrier { unsigned* bar; unsigned x; volatile LAS unsigned* st; int wave; };
__device__ __forceinline__ XcdBarrier xcd_barrier_post(unsigned* bar, volatile LAS unsigned* st, int wave) {
    XcdBarrier b; b.bar = bar; b.x = xb_xcc_id(); b.st = st; b.wave = wave;
    if (wave == 0 && lane_id() == 0) (void)xb_add(&bar[XB_XCNT(b.x)], 1u);
    return b;
}
__device__ __forceinline__ void xcd_barrier_complete(unsigned* bar, unsigned x, unsigned& nloc, unsigned& nx) {
    const unsigned G = gridDim.x * gridDim.y * gridDim.z;
    unsigned sum, cnt, mine, sp = 0u;
    for (;;) {
        sum = 0u; cnt = 0u; mine = 0u;
#pragma unroll
        for (unsigned j = 0; j < 16; ++j) { const unsigned c = xb_ld(&bar[XB_XCNT(j)]); sum += c; cnt += (c > 0u) ? 1u : 0u; mine = (j == x) ? c : mine; }
        if (sum == G) break;
        __builtin_amdgcn_s_sleep(1);
        if ((++sp & 255u) == 0u) { if (xb_ld(&bar[XB_TMO])) break; if (sp > XB_SPIN_CAP) { atomicAdd(&bar[XB_TMO], 1u); break; } }
    }
    nloc = mine > 0u ? mine : 1u; nx = cnt > 0u ? cnt : 1u;
}
__device__ __forceinline__ void xcd_barrier(const XcdBarrier& b) {
    asm volatile("s_waitcnt vmcnt(0)" ::: "memory");
    __syncthreads();
    if (b.wave == 0 && lane_id() == 0) {
        unsigned* bar = b.bar;
        __builtin_amdgcn_s_waitcnt(0);
        unsigned nloc = b.st[0], nx = b.st[1];
        if (nloc == 0u) { xcd_barrier_complete(bar, b.x, nloc, nx); b.st[0] = nloc; b.st[1] = nx; }
        const unsigned old = xb_add(&bar[XB_XSUB(b.x)], 1u);
        const unsigned gen = old / nloc;
        if (old + 1u == (gen + 1u) * nloc) {
            __builtin_amdgcn_fence(__ATOMIC_RELEASE, "agent");
            asm volatile("s_waitcnt vmcnt(0)" ::: "memory");
            const unsigned og = xb_add(&bar[XB_TOP], 1u);
            const unsigned tg = og / nx;
            if (og + 1u == (tg + 1u) * nx) xb_add(&bar[XB_TOPGEN], 1u);
            else XB_SPIN(xb_ld(&bar[XB_TOPGEN]) == tg, bar);
            __builtin_amdgcn_fence(__ATOMIC_ACQUIRE, "agent");
            xb_add(&bar[XB_XGEN(b.x)], 1u);
            asm volatile("s_waitcnt vmcnt(0)" ::: "memory");
        } else {
            XB_SPIN(xb_ld(&bar[XB_XGEN(b.x)]) == gen, bar);
            __builtin_amdgcn_fence(__ATOMIC_ACQUIRE, "agent");
            asm volatile("s_waitcnt vmcnt(0)" ::: "memory");
        }
    }
    __syncthreads();
}

constexpr int RING_OFF = 0, RING_BYTES = 131072;
constexpr int LDSCTL_OFF = RING_BYTES, MISC_OFF = LDSCTL_OFF + 320;
constexpr int LDS_BYTES = 147456;

struct Args {
    const float* in[22];
    float* out; unsigned char* ws;
    int ph_lo, ph_hi;
};

struct Frame {
    LAS unsigned char* lds;
    int wave, vcu, G;
};

__device__ __forceinline__ void tr_item(const float* W, int ldw, const float* gain, int k0, int c0, int cn, bf16* WT, int ldt, int drow0, int dk0, LAS float* scr, int lane) {
    { const int rsub = lane >> 3, c4 = (lane & 7) * 4; f32x4 v[8];
#pragma unroll
      for (int i = 0; i < 8; ++i) v[i] = (c4 < cn) ? *(const f32x4*)(W + (size_t)(k0 + 8 * i + rsub) * ldw + c0 + c4) : (f32x4){0.f, 0.f, 0.f, 0.f};
#pragma unroll
      for (int i = 0; i < 8; ++i) { const int kk = 8 * i + rsub; const float g_ = gain ? gain[k0 + kk] : 1.0f; LAS float* d = scr + kk * 33 + c4;
          d[0] = v[i].x * g_; d[1] = v[i].y * g_; d[2] = v[i].z * g_; d[3] = v[i].w * g_; } }
    LDS_WAIT(); asm volatile("" ::: "memory");
    const int c = lane & 7;
#pragma unroll
    for (int j = 0; j < 4; ++j) { const int n = (lane >> 3) + 8 * j; const LAS float* s = scr + (8 * c) * 33 + n;
        u32x4 o; o.x = cvt_pk_bf16(s[0 * 33], s[1 * 33]); o.y = cvt_pk_bf16(s[2 * 33], s[3 * 33]); o.z = cvt_pk_bf16(s[4 * 33], s[5 * 33]); o.w = cvt_pk_bf16(s[6 * 33], s[7 * 33]);
        if (n < cn) *(u32x4*)(WT + (size_t)(drow0 + n) * ldt + dk0 + 8 * c) = o; }
    LDS_WAIT(); asm volatile("" ::: "memory");
}
__device__ const int WIN_SEG[13][3] = {
    {0, 1024, 0}, {1024, 1536, 1024}, {2560, 24, 11264 + 80}, {2584, 1024, 2560}, {3608, 1024, 3584}, {4632, 256, 4608}, {4888, 256, 4864},
    {5144, 1024, 5120}, {6168, 64, 11264}, {6232, 16, 11264 + 64}, {6248, 1024, 6144}, {7272, 2048, 7168}, {9320, 2048, 9216}};
__device__ const int WIN_CB[14] = {0, 32, 80, 81, 113, 145, 153, 161, 193, 195, 196, 228, 292, 356};

constexpr int TR_I_WIN = 356 * 32, TR_I_UP = 64 * 16, TR_I_SQ = 64 * 32, TR_I_PP = 64 * 4, TR_I_C1 = 8 * 32;
constexpr int TR_EARLY = TR_I_WIN + TR_I_PP, TR_NITEMS = TR_EARLY + 2 * TR_I_UP + 2 * TR_I_SQ + 4 * TR_I_C1;
__device__ __forceinline__ void tr_items(const Args& a, LAS float* scr, int lo, int hi, int gw, int NGW, int lane) {
    unsigned char* ws = a.ws;
    for (int it = lo + gw; it < hi; it += NGW) {
        int r = it;
        if (r < TR_I_WIN) { const int cb = r >> 5, kb = r & 31; int sg = 0;
#pragma unroll
            for (int s = 1; s < 13; ++s) if (cb >= WIN_CB[s]) sg = s;
            const int off = (cb - WIN_CB[sg]) * 32, len = WIN_SEG[sg][1]; const int cn = (len - off) < 32 ? (len - off) : 32;
            tr_item(a.in[3], NIN, a.in[2], kb * 64, WIN_SEG[sg][0] + off, cn, (bf16*)(ws + WS_WIN), DM, WIN_SEG[sg][2] + off, kb * 64, scr, lane); continue; }
        r -= TR_I_WIN;
        if (r < TR_I_PP) { tr_item(a.in[21], DM, nullptr, (r & 3) * 64, (r >> 2) * 32, 32, (bf16*)(ws + WS_WPP), 256, (r >> 2) * 32, (r & 3) * 64, scr, lane); continue; } r -= TR_I_PP;
        if (r < TR_I_UP) { tr_item(a.in[16], DM, nullptr, (r & 15) * 64, (r >> 4) * 32, 32, (bf16*)(ws + WS_WUPN), 1024, (r >> 4) * 32, (r & 15) * 64, scr, lane); continue; } r -= TR_I_UP;
        if (r < TR_I_UP) { tr_item(a.in[17], DM, nullptr, (r & 15) * 64, (r >> 4) * 32, 32, (bf16*)(ws + WS_WUPD), 1024, (r >> 4) * 32, (r & 15) * 64, scr, lane); continue; } r -= TR_I_UP;
        if (r < TR_I_SQ) { tr_item(a.in[18], DM, nullptr, (r & 31) * 64, (r >> 5) * 32, 32, (bf16*)(ws + WS_WOUT), DM, (r >> 5) * 32, (r & 31) * 64, scr, lane); continue; } r -= TR_I_SQ;
        if (r < TR_I_SQ) { tr_item(a.in[20], DM, a.in[19], (r & 31) * 64, (r >> 5) * 32, 32, (bf16*)(ws + WS_WG), DM, (r >> 5) * 32, (r & 31) * 64, scr, lane); continue; } r -= TR_I_SQ;
        { const int which = r / (2 * TR_I_C1); r -= which * 2 * TR_I_C1; const int hi_ = r / TR_I_C1; r -= hi_ * TR_I_C1;
          const float* W = which ? a.in[12] : a.in[9]; bf16* WT = (bf16*)(ws + (which ? WS_WC1V : WS_WC1K));
          tr_item(W, 256, nullptr, hi_ * 2048 + (r & 31) * 64, (r >> 5) * 32, 32, WT, 2048, hi_ * 256 + (r >> 5) * 32, (r & 31) * 64, scr, lane); }
    }
}

__device__ __forceinline__ void p0_prologue(const Frame& F, const Args& a) {
    unsigned char* ws = a.ws;
    LAS float* scr = (LAS float*)(F.lds + RING_OFF + F.wave * 16384);
    const int gw = F.vcu * NWAVES + F.wave, NGW = F.G * NWAVES, lane = lane_id();
    tr_items(a, scr, 0, TR_EARLY, gw, NGW, lane);
    { bf16* WT = (bf16*)(ws + WS_WIN) + (size_t)(11264 + 104) * DM; const size_t n16 = (size_t)152 * DM * 2 / 16;
      for (size_t i = (size_t)gw * 64 + lane; i < n16; i += (size_t)NGW * 64) ((u32x4*)WT)[i] = (u32x4){0u, 0u, 0u, 0u}; }
    if (gw < 10) { const int i = gw * 64 + lane, k = i >> 7; const float* gp = k == 0 ? a.in[4] : k == 1 ? a.in[6] : k == 2 ? a.in[7] : k == 3 ? a.in[14] : a.in[15];
      ((float*)(ws + WS_GN))[i] = gp[i & 127] * ((k == 0 || k == 3) ? QSCALE : 1.0f); }
    for (int m = gw; m < T; m += NGW) {
        const f32x4* xr = (const f32x4*)(a.in[0] + (size_t)m * DM) + lane;
        f32x4 v[8]; float s = 0.f;
#pragma unroll
        for (int j = 0; j < 8; ++j) { v[j] = xr[64 * j]; s += (v[j].x * v[j].x + v[j].y * v[j].y) + (v[j].z * v[j].z + v[j].w * v[j].w); }
        s = wave_sum(s);
        u32x2* o8 = (u32x2*)((bf16*)(ws + WS_XB) + (size_t)m * DM) + lane;
#pragma unroll
        for (int j = 0; j < 8; ++j) o8[64 * j] = (u32x2){cvt_pk_bf16(v[j].x, v[j].y), cvt_pk_bf16(v[j].z, v[j].w)};
        if (lane == 0) ((float*)(ws + WS_R0))[m] = 1.0f / sqrtf(s * (1.0f / DM) + EPS);
    }
    { const size_t n8 = (size_t)T * 256 / 8; const f32x4* src = (const f32x4*)a.in[1]; u32x4* dst = (u32x4*)(ws + WS_PB);
      for (size_t i = (size_t)gw * 64 + lane; i < n8; i += (size_t)NGW * 64) { const f32x4 x0 = src[2 * i], x1 = src[2 * i + 1];
          dst[i] = (u32x4){cvt_pk_bf16(x0.x, x0.y), cvt_pk_bf16(x0.z, x0.w), cvt_pk_bf16(x1.x, x1.y), cvt_pk_bf16(x1.z, x1.w)}; } }
    for (int it = gw; it < 2 * 64 * 4; it += NGW) { const int which = it >> 8, c = (it >> 2) & 63, jq = it & 3, j = jq * 64 + lane;
        const float* pe = which ? a.in[11] : a.in[8]; const float* W = which ? a.in[12] : a.in[9];
        float s = 0.f;
#pragma unroll 8
        for (int k = c * 64; k < c * 64 + 64; ++k) s += pe[k] * W[(size_t)k * 256 + j];
        ((float*)(ws + WS_BIASP))[(which * 64 + c) * 256 + j] = s; }
}

struct SchedPlain {
    pg8::TileOrder to; int G, c; const char* A; const char* B; size_t at, bt;
    __device__ __forceinline__ bool next(int i, pg8::Unit& u) const {
        if (c < 0) return false;
        const long L = (long)i * G + c; if (L >= to.nwg) return false;
        to.tile((int)L, u.pm, u.pn); u.tag = 0; u.A = A + (size_t)u.pm * at; u.B = B + (size_t)u.pn * bt; return true; }
};
struct SchedChain {
    pg8::TileOrder to; int G, c; const char* A0; const char* B0; const char* A1; const char* B1; size_t at, bt;
    __device__ __forceinline__ bool next(int i, pg8::Unit& u) const {
        const long L = (long)(i >> 1) * G + c; if (L >= to.nwg) return false;
        to.tile((int)L, u.pm, u.pn); u.tag = i & 1; u.A = ((i & 1) ? A1 : A0) + (size_t)u.pm * at; u.B = ((i & 1) ? B1 : B0) + (size_t)u.pn * bt; return true; }
};
struct SchedCmp {
    int c; const char* A0; const char* A1; const char* B0; const char* B1;
    __device__ __forceinline__ bool next(int i, pg8::Unit& u) const {
        if (i > 0 || c >= 128) return false;
        const int unit = c >> 2, split = c & 3, kv = unit >> 4, rem = unit & 15; u.pm = rem >> 1; u.pn = rem & 1; u.tag = kv * 4 + split;
        u.A = (kv ? A1 : A0) + (size_t)u.pm * (256u * 2048u * 2u) + (size_t)split * 1024u; u.B = (kv ? B1 : B0) + (size_t)u.pn * (256u * 2048u * 2u) + (size_t)split * 1024u; return true; }
};

__device__ __forceinline__ u32x4 pack8(const f32x4 v0, const f32x4 v1) { return (u32x4){cvt_pk_bf16(v0[0], v0[1]), cvt_pk_bf16(v0[2], v0[3]), cvt_pk_bf16(v1[0], v1[1]), cvt_pk_bf16(v1[2], v1[3])}; }
__device__ __forceinline__ u32x4 pack8h(const f32x4 v0, const f32x4 v1) { return (u32x4){cvt_pk_f16(v0[0], v0[1]), cvt_pk_f16(v0[2], v0[3]), cvt_pk_f16(v1[0], v1[1]), cvt_pk_f16(v1[2], v1[3])}; }
__device__ __forceinline__ void unpack8(const u32x4 w, f32x4& v0, f32x4& v1) { v0 = (f32x4){bf_lo(w.x), bf_hi(w.x), bf_lo(w.y), bf_hi(w.y)}; v1 = (f32x4){bf_lo(w.z), bf_hi(w.z), bf_lo(w.w), bf_hi(w.w)}; }

struct EpiInProj {
    unsigned char* ws; bf16* MGN; bf16* MGD; LAS float* P;
    __device__ __forceinline__ bool operator()(f32x4 (&acc)[2][2][4][2], const pg8::Unit& u, int wr, int wc, int fr, int fq) const {
        const int pn = u.pn, row0 = u.pm * 256 + wr * 64 + fr, colw = wc * 32 + 8 * fq;
        const float* R0 = (const float*)(ws + WS_R0);
        float rs[2][4];
#pragma unroll
        for (int ai = 0; ai < 2; ++ai)
#pragma unroll
            for (int m = 0; m < 4; ++m) rs[ai][m] = R0[row0 + ai * 128 + m * 16];
        if (pn < 4 || pn == 6 || pn == 8 || (pn >= 14 && pn <= 18)) {
#pragma unroll
            for (int ai = 0; ai < 2; ++ai)
#pragma unroll
                for (int m = 0; m < 4; ++m)
#pragma unroll
                    for (int bj = 0; bj < 2; ++bj) { const f32x4 v0 = acc[ai][bj][m][0] * rs[ai][m], v1 = acc[ai][bj][m][1] * rs[ai][m];
                        acc[ai][bj][m][0] = v0; acc[ai][bj][m][1] = v1;
                        float ss = v0[0] * v0[0] + v0[1] * v0[1] + v0[2] * v0[2] + v0[3] * v0[3] + v1[0] * v1[0] + v1[1] * v1[1] + v1[2] * v1[2] + v1[3] * v1[3];
                        ss += __shfl_xor(ss, 16); ss += __shfl_xor(ss, 32);
                        if (fq == 0) P[((ai * 128 + wr * 64 + m * 16 + fr) * 2 + bj) * 4 + wc] = ss; }
            asm volatile("s_waitcnt lgkmcnt(0)" ::: "memory"); __builtin_amdgcn_s_barrier(); asm volatile("" ::: "memory");
            const float* gp = (const float*)(ws + WS_GN) + (pn < 4 ? 0 : pn == 6 ? 128 : pn == 8 ? 256 : pn < 18 ? 384 : 512) + colw;
            const f32x4 g0 = *(const f32x4*)gp, g1 = *(const f32x4*)(gp + 4);
#pragma unroll
            for (int ai = 0; ai < 2; ++ai)
#pragma unroll
                for (int m = 0; m < 4; ++m) {
#pragma unroll
                    for (int bj = 0; bj < 2; ++bj) { const f32x4 pp = *(LAS f32x4*)&P[((ai * 128 + wr * 64 + m * 16 + fr) * 2 + bj) * 4];
                        const float rr = 1.0f / sqrtf((pp[0] + pp[1] + pp[2] + pp[3]) * (1.0f / 128.0f) + EPS);
                        acc[ai][bj][m][0] = acc[ai][bj][m][0] * rr * g0; acc[ai][bj][m][1] = acc[ai][bj][m][1] * rr * g1; }
                    rs[ai][m] = 1.0f; }
        }
        if (pn == 44) {
#pragma unroll
            for (int ai = 0; ai < 2; ++ai)
#pragma unroll
                for (int m = 0; m < 4; ++m) { const int row = row0 + ai * 128 + m * 16; const f32x4 v0 = acc[ai][0][m][0] * rs[ai][m], v1 = acc[ai][0][m][1] * rs[ai][m];
                    if (colw < 64) *(u32x4*)((bf16*)(ws + WS_IK) + (size_t)row * 64 + colw) = pack8h(v0, v1);
                    else if (colw < 104) { float* p = (float*)(ws + WS_MISC) + (size_t)row * 40 + (colw - 64); *(f32x4*)p = v0; *(f32x4*)(p + 4) = v1; } }
            return false;
        }
        bf16* p0; size_t d1 = 128; int ldc = 1024, act = 0;
        if (pn < 4) p0 = (bf16*)(ws + WS_QN) + pn * 256;
        else if (pn < 10) { const size_t offs = pn == 4 ? WS_KCR : pn == 5 ? WS_VCR : pn == 6 ? WS_KS : pn == 7 ? WS_VS : pn == 8 ? WS_KW : WS_VW;
            p0 = (bf16*)(ws + offs) + (size_t)(u.pm >> 5) * S * 128; ldc = 128; d1 = (size_t)S * 128; }
        else if (pn < 14) { p0 = (bf16*)(ws + WS_NZ) + (pn - 10) * 256; act = 1; }
        else if (pn < 18) p0 = (bf16*)(ws + WS_DQ) + (pn - 14) * 256;
        else if (pn < 20) { p0 = (bf16*)(ws + (pn == 18 ? WS_DK : WS_DV)); ldc = 256; }
        else if (pn < 24) { p0 = (bf16*)(ws + WS_IQ) + (pn - 20) * 256; act = 3; }
        else if (pn < 28) { p0 = (bf16*)(ws + WS_DZ) + (pn - 24) * 256; act = 1; }
        else if (pn < 36) { p0 = MGN + (pn - 28) * 256; ldc = 2048; act = 2; }
        else { p0 = MGD + (pn - 36) * 256; ldc = 2048; act = 2; }
#pragma unroll
        for (int ai = 0; ai < 2; ++ai)
#pragma unroll
            for (int m = 0; m < 4; ++m) { bf16* rowp = p0 + (size_t)(row0 + ai * 128 + m * 16) * ldc + colw;
#pragma unroll
                for (int bj = 0; bj < 2; ++bj) { f32x4 v0 = acc[ai][bj][m][0] * rs[ai][m], v1 = acc[ai][bj][m][1] * rs[ai][m];
                    if (act == 1 || act == 2) {
#pragma unroll
                        for (int j = 0; j < 4; ++j) { const float s0 = sigmoidf_(v0[j]), s1 = sigmoidf_(v1[j]); v0[j] = act == 1 ? v0[j] * s0 : s0; v1[j] = act == 1 ? v1[j] * s1 : s1; } }
                    __builtin_nontemporal_store(act == 3 ? pack8h(v0, v1) : pack8(v0, v1), (u32x4*)(rowp + bj * d1)); } }
        return false;
    }
};
struct SchedTail {
    int G, c; const char* A; const char* B; size_t at;
    __device__ __forceinline__ bool next(int i, pg8::Unit& u) const {
        if (c < 0) return false;
        const long L = (long)i * G + c; if (L >= T / 256) return false;
        u.pm = (int)L; u.pn = 44; u.tag = 0; u.A = A + (size_t)u.pm * at; u.B = B; return true; }
};
struct EpiMisc {
    unsigned char* ws;
    __device__ __forceinline__ bool operator()(f32x4 (&acc)[2][2][4][2], const pg8::Unit& u, int wr, int wc, int fr, int fq) const {
        const int row0 = u.pm * 256 + wr * 64 + fr, colw = wc * 32 + 8 * fq;
        const float* R0 = (const float*)(ws + WS_R0);
#pragma unroll
        for (int ai = 0; ai < 2; ++ai)
#pragma unroll
            for (int m = 0; m < 4; ++m) { const int row = row0 + ai * 128 + m * 16; const float rs = R0[row]; const f32x4 v0 = acc[ai][0][m][0] * rs, v1 = acc[ai][0][m][1] * rs;
                if (colw < 64) *(u32x4*)((bf16*)(ws + WS_IK) + (size_t)row * 64 + colw) = pack8h(v0, v1);
                else if (colw < 104) { float* p = (float*)(ws + WS_MISC) + (size_t)row * 40 + (colw - 64); *(f32x4*)p = v0; *(f32x4*)(p + 4) = v1; } }
        return false;
    }
};
struct EpiBf16Plain {
    bf16* O; int ldc;
    __device__ __forceinline__ bool operator()(f32x4 (&acc)[2][2][4][2], const pg8::Unit& u, int wr, int wc, int fr, int fq) const {
        const int row0 = u.pm * 256 + wr * 64 + fr, col0 = u.pn * 256 + wc * 32 + 8 * fq;
#pragma unroll
        for (int ai = 0; ai < 2; ++ai)
#pragma unroll
            for (int m = 0; m < 4; ++m) { bf16* rowp = O + (size_t)(row0 + ai * 128 + m * 16) * ldc + col0;
#pragma unroll
                for (int bj = 0; bj < 2; ++bj) *(u32x4*)(rowp + bj * 128) = pack8(acc[ai][bj][m][0], acc[ai][bj][m][1]); }
        return false;
    }
};
struct EpiCmp {
    float* CP;
    __device__ __forceinline__ bool operator()(f32x4 (&acc)[2][2][4][2], const pg8::Unit& u, int wr, int wc, int fr, int fq) const {
        const int row0 = u.pm * 256 + wr * 64 + fr, col0 = u.pn * 256 + wc * 32 + 8 * fq;
        float* base = CP + (size_t)((u.tag & 3) * 2 + (u.tag >> 2)) * 2048 * 512;
#pragma unroll
        for (int ai = 0; ai < 2; ++ai)
#pragma unroll
            for (int m = 0; m < 4; ++m) { float* rowp = base + (size_t)(row0 + ai * 128 + m * 16) * 512 + col0;
#pragma unroll
                for (int bj = 0; bj < 2; ++bj) { *(f32x4*)(rowp + bj * 128) = acc[ai][bj][m][0]; *(f32x4*)(rowp + bj * 128 + 4) = acc[ai][bj][m][1]; } }
        return false;
    }
};
struct EpiY {
    const bf16* MGN; const bf16* MGD; bf16* Y;
    __device__ __forceinline__ bool operator()(f32x4 (&acc)[2][2][4][2], const pg8::Unit& u, int wr, int wc, int fr, int fq) const {
        const int row0 = u.pm * 256 + wr * 64 + fr, col0 = u.pn * 256 + wc * 32 + 8 * fq;
#pragma unroll
        for (int ai = 0; ai < 2; ++ai)
#pragma unroll
            for (int m = 0; m < 4; ++m) { const size_t off = (size_t)(row0 + ai * 128 + m * 16) * DM + col0;
#pragma unroll
                for (int bj = 0; bj < 2; ++bj) { f32x4 b0, b1; unpack8(*(const u32x4*)(MGD + off + bj * 128), b0, b1);
                    if (u.tag == 0) { f32x4 a0, a1; unpack8(*(const u32x4*)(MGN + off + bj * 128), a0, a1);
#pragma unroll
                        for (int j = 0; j < 4; ++j) { acc[ai][bj][m][0][j] *= a0[j] * __builtin_amdgcn_rcpf(b0[j]); acc[ai][bj][m][1][j] *= a1[j] * __builtin_amdgcn_rcpf(b1[j]); } }
                    else { u32x4 yv = pack8(acc[ai][bj][m][0] * b0, acc[ai][bj][m][1] * b1);
#ifdef DBG_T
                        if (((row0 + ai * 128 + m * 16) & (S - 1)) < DBG_T) yv = (u32x4){0u, 0u, 0u, 0u};
#endif
                        *(u32x4*)(Y + off + bj * 128) = yv; } } }
        return u.tag == 0;
    }
};
struct EpiX1 {
    const float* X; float* OUT; bf16* X1B; float* SS1;
    __device__ __forceinline__ bool operator()(f32x4 (&acc)[2][2][4][2], const pg8::Unit& u, int wr, int wc, int fr, int fq) const {
        const int row0 = u.pm * 256 + wr * 64 + fr, col0 = u.pn * 256 + wc * 32 + 8 * fq;
#pragma unroll
        for (int ai = 0; ai < 2; ++ai)
#pragma unroll
            for (int m = 0; m < 4; ++m) { const int row = row0 + ai * 128 + m * 16; const size_t off = (size_t)row * DM + col0; float ss = 0.f;
#pragma unroll
                for (int bj = 0; bj < 2; ++bj) { const f32x4 x0 = *(const f32x4*)(X + off + bj * 128), x1 = *(const f32x4*)(X + off + bj * 128 + 4);
                    const f32x4 v0 = x0 + acc[ai][bj][m][0], v1 = x1 + acc[ai][bj][m][1];
                    __builtin_nontemporal_store(v0, (f32x4*)(OUT + off + bj * 128)); __builtin_nontemporal_store(v1, (f32x4*)(OUT + off + bj * 128 + 4)); *(u32x4*)(X1B + off + bj * 128) = pack8(v0, v1);
                    ss += (v0[0] * v0[0] + v0[1] * v0[1]) + (v0[2] * v0[2] + v0[3] * v0[3]) + (v1[0] * v1[0] + v1[1] * v1[1]) + (v1[2] * v1[2] + v1[3] * v1[3]); }
                ss += __shfl_xor(ss, 16); ss += __shfl_xor(ss, 32);
                if (fq == 0) atomicAdd(SS1 + row, ss); }
        return false;
    }
};
struct EpiFinal {
    float* OUT; const bf16* PP; const float* SS1;
    __device__ __forceinline__ bool operator()(f32x4 (&acc)[2][2][4][2], const pg8::Unit& u, int wr, int wc, int fr, int fq) const {
        const int row0 = u.pm * 256 + wr * 64 + fr, col0 = u.pn * 256 + wc * 32 + 8 * fq;
#pragma unroll
        for (int ai = 0; ai < 2; ++ai)
#pragma unroll
            for (int m = 0; m < 4; ++m) { const int row = row0 + ai * 128 + m * 16; const size_t off = (size_t)row * DM + col0;
                const float r1 = 1.0f / sqrtf(SS1[row] * (1.0f / DM) + EPS);
#pragma unroll
                for (int bj = 0; bj < 2; ++bj) { f32x4 p0, p1; unpack8(*(const u32x4*)(PP + off + bj * 128), p0, p1);
                    f32x4 v0 = *(const f32x4*)(OUT + off + bj * 128), v1 = *(const f32x4*)(OUT + off + bj * 128 + 4);
#pragma unroll
                    for (int j = 0; j < 4; ++j) { v0[j] += p0[j] * sigmoidf_(acc[ai][bj][m][0][j] * r1); v1[j] += p1[j] * sigmoidf_(acc[ai][bj][m][1][j] * r1); }
                    __builtin_nontemporal_store(v0, (f32x4*)(OUT + off + bj * 128)); __builtin_nontemporal_store(v1, (f32x4*)(OUT + off + bj * 128 + 4)); } }
        return false;
    }
};

__device__ __forceinline__ void norm_rows(bf16* base, size_t nrows, const float* gain, float cs, int gw, int NGW, int lane) {
    const int sub = lane >> 4, c = lane & 15;
    f32x4 g0 = *(const f32x4*)(gain + c * 8), g1 = *(const f32x4*)(gain + c * 8 + 4);
    g0 = g0 * cs; g1 = g1 * cs;
    for (size_t r = (size_t)gw * 4 + sub; r < nrows; r += (size_t)NGW * 4) {
        u32x4* p = (u32x4*)(base + r * 128) + c; const u32x4 w = *p; f32x4 v0, v1; unpack8(w, v0, v1);
        float ss = (v0[0] * v0[0] + v0[1] * v0[1]) + (v0[2] * v0[2] + v0[3] * v0[3]) + (v1[0] * v1[0] + v1[1] * v1[1]) + (v1[2] * v1[2] + v1[3] * v1[3]);
        ss += __shfl_xor(ss, 1); ss += __shfl_xor(ss, 2); ss += __shfl_xor(ss, 4); ss += __shfl_xor(ss, 8);
        const float rr = 1.0f / sqrtf(ss * (1.0f / 128.0f) + EPS);
        *p = pack8(v0 * rr * g0, v1 * rr * g1);
    }
}

__device__ __forceinline__ void cmp2_task(const Args& a, int task, LAS float* hbuf, int lane) {
    unsigned char* ws = a.ws;
    const int which = task >> 9, bg = (task >> 7) & 3, n0 = (task & 127) * 4;
    const float* CP = (const float*)(ws + WS_CP4) + (size_t)which * 2048 * 512; const float* BP = (const float*)(ws + WS_BIAS) + which * 256;
    float bias[4];
#pragma unroll
    for (int q = 0; q < 4; ++q) bias[q] = BP[q * 64 + lane];
#pragma unroll
    for (int r = 0; r < 4; ++r) { const int n = n0 + r, n1 = (n + 1) < 512 ? (n + 1) : 511;
#pragma unroll
        for (int q = 0; q < 4; ++q) { const int j = q * 64 + lane;
            float v = bias[q];
#pragma unroll
            for (int sp = 0; sp < 4; ++sp) v += CP[(size_t)sp * 2 * 2048 * 512 + (size_t)(bg * 512 + n) * 512 + j] + CP[(size_t)sp * 2 * 2048 * 512 + (size_t)(bg * 512 + n1) * 512 + 256 + j];
            hbuf[r * 256 + j] = v * sigmoidf_(v); } }
    LDS_WAIT(); asm volatile("" ::: "memory");
    const float* W2 = which ? a.in[13] : a.in[10];
    f32x2 o[4] = {{0.f, 0.f}, {0.f, 0.f}, {0.f, 0.f}, {0.f, 0.f}};
#pragma unroll 4
    for (int j = 0; j < 256; ++j) { const f32x2 w = *(const f32x2*)(W2 + j * 128 + 2 * lane);
#pragma unroll
        for (int r = 0; r < 4; ++r) { const float h = hbuf[r * 256 + j]; o[r].x += h * w.x; o[r].y += h * w.y; } }
    bf16* dst = (bf16*)(ws + (which ? WS_VC : WS_KC)) + (size_t)bg * 512 * 128;
    const f32x2 g = which ? (f32x2){1.f, 1.f} : *(const f32x2*)(a.in[5] + 2 * lane);
#pragma unroll
    for (int r = 0; r < 4; ++r) { float sc = 1.f;
        if (!which) { const float ss = wave_sum(o[r].x * o[r].x + o[r].y * o[r].y); sc = 1.0f / sqrtf(ss * (1.0f / 128.0f) + EPS); }
        ((unsigned*)(dst + (size_t)(n0 + r) * 128))[lane] = cvt_pk_bf16(o[r].x * sc * g.x, o[r].y * sc * g.y); }
    LDS_WAIT(); asm volatile("" ::: "memory");
}

namespace dsa {
typedef short s16x4 __attribute__((ext_vector_type(4)));
typedef unsigned short u16x4 __attribute__((ext_vector_type(4)));
constexpr int L_HIST = 0, L_H1 = 16384, L_H2 = 49152, L_H3 = 81920, L_CNT = 83968, L_THR = 86016, L_MM = 86272, L_CCNT = 86528, L_CAND = 86784, L_SEG = 90880, L_WCNT = 107264, L_IDX = 107520, L_PF = 109568, CAP = 256;
constexpr int VROW = 288, VST_W = 32 * VROW, KROW = 272, LB_WAVE = 512 + VST_W + 16 * KROW;
static_assert(L_IDX + 2048 <= 131072 && 8 * LB_WAVE <= 131072 && L_CAND + 4 * CAP * 4 <= L_SEG && L_SEG + 4 * 8 * 256 * 2 <= L_WCNT, "dsa LDS map");

__device__ __forceinline__ unsigned f2key(float f) { const unsigned u = __float_as_uint(f); return (u & 0x80000000u) ? ~u : (u | 0x80000000u); }
__device__ __forceinline__ float key2f(unsigned k) { return __uint_as_float((k & 0x80000000u) ? (k & 0x7fffffffu) : ~k); }
constexpr unsigned KY_INV = 0x7fc00000u;
__device__ __forceinline__ unsigned kykey(unsigned fb) { return fb == KY_INV ? 0u : f2key(__uint_as_float(fb)); }
__device__ __forceinline__ void lds_add(LAS unsigned* p, unsigned v) { (void)__hip_atomic_fetch_add(p, v, __ATOMIC_RELAXED, __HIP_MEMORY_SCOPE_WORKGROUP); }

template <int WPL>
__device__ __forceinline__ void scan_hist(const LAS unsigned* H, unsigned need, int lane, unsigned& T, unsigned& cab, unsigned& cat) {
    unsigned wv[WPL];
    if constexpr (WPL >= 4) {
#pragma unroll
        for (int j = 0; j < WPL / 4; ++j) { const u32x4 x = *(const LAS u32x4*)(H + WPL * lane + 4 * j); wv[4 * j] = x.x; wv[4 * j + 1] = x.y; wv[4 * j + 2] = x.z; wv[4 * j + 3] = x.w; }
    } else {
        const u32x2 x = *(const LAS u32x2*)(H + 2 * lane); wv[0] = x.x; wv[1] = x.y;
    }
    unsigned tot = 0;
#pragma unroll
    for (int j = 0; j < WPL; ++j) tot += (wv[j] & 0xffffu) + (wv[j] >> 16);
    unsigned incl = tot;
#pragma unroll
    for (int o = 1; o < 64; o <<= 1) { const unsigned v = __shfl_down(incl, o); if (lane + o < 64) incl += v; }
    const unsigned above = incl - tot;
    const bool mine = (above < need) && (need <= incl);
    unsigned running = above, Tl = 0, cb = 0, ct = 0; bool found = false;
#pragma unroll
    for (int j = 2 * WPL - 1; j >= 0; --j) { const unsigned c = (wv[j >> 1] >> (16 * (j & 1))) & 0xffffu;
        const bool hit = !found && (running + c >= need);
        if (hit) { Tl = (unsigned)j; cb = running; ct = c; found = true; }
        running += c; }
    const unsigned long long bm = __ballot(mine);
    const int L = bm ? (__ffsll((long long)bm) - 1) : 0;
    T = (unsigned)__builtin_amdgcn_readlane((int)(2 * WPL * lane + Tl), L);
    cab = (unsigned)__builtin_amdgcn_readlane((int)cb, L);
    cat = (unsigned)__builtin_amdgcn_readlane((int)ct, L);
}

__device__ __forceinline__ void scan_hist32(const LAS unsigned* H, unsigned need, int lane, unsigned& T, unsigned& cab, unsigned& cat) {
    unsigned wv[16];
#pragma unroll
    for (int j = 0; j < 4; ++j) { const u32x4 x = *(const LAS u32x4*)(H + 16 * lane + 4 * j); wv[4 * j] = x.x; wv[4 * j + 1] = x.y; wv[4 * j + 2] = x.z; wv[4 * j + 3] = x.w; }
    unsigned tot = 0;
#pragma unroll
    for (int j = 0; j < 16; ++j) tot += wv[j];
    unsigned incl = tot;
#pragma unroll
    for (int o = 1; o < 64; o <<= 1) { const unsigned v = __shfl_down(incl, o); if (lane + o < 64) incl += v; }
    const unsigned above = incl - tot;
    const bool mine = (above < need) && (need <= incl);
    unsigned running = above, Tl = 0, cb = 0, ct = 0; bool found = false;
#pragma unroll
    for (int j = 15; j >= 0; --j) { const unsigned c = wv[j];
        const bool hit = !found && (running + c >= need);
        if (hit) { Tl = (unsigned)j; cb = running; ct = c; found = true; }
        running += c; }
    const unsigned long long bm = __ballot(mine);
    const int L = bm ? (__ffsll((long long)bm) - 1) : 0;
    T = (unsigned)__builtin_amdgcn_readlane((int)(16 * lane + Tl), L);
    cab = (unsigned)__builtin_amdgcn_readlane((int)cb, L);
    cat = (unsigned)__builtin_amdgcn_readlane((int)ct, L);
}

__device__ __forceinline__ float med3_0(float x, float c) { return __builtin_amdgcn_fmed3f(x, 0.f, c); }
#define DSA_BAR do { asm volatile("s_waitcnt lgkmcnt(0)" ::: "memory"); __builtin_amdgcn_s_barrier(); asm volatile("" ::: "memory"); } while (0)
template <int PM>
__device__ __forceinline__ void dsa_select_tile(unsigned char* ws, LAS unsigned char* lds, const int b, const int t0, const int lane_in, const int w_in, const int dry, const int nrow) {
    int w = w_in; asm volatile("" : "+s"(w));
    int lane = lane_in; asm volatile("" : "+v"(lane));
    const int tid = w * 64 + lane;
    const int i16 = lane & 15, kg = lane >> 4;
    LAS unsigned* HIST = (LAS unsigned*)(lds + L_HIST);
    LAS unsigned* H1 = (LAS unsigned*)(lds + L_H1); LAS unsigned* H2 = (LAS unsigned*)(lds + L_H2); LAS unsigned* H3 = (LAS unsigned*)(lds + L_H3);
    LAS unsigned* CNT = (LAS unsigned*)(lds + L_CNT); LAS unsigned* THR = (LAS unsigned*)(lds + L_THR); LAS unsigned* MM = (LAS unsigned*)(lds + L_MM);
    LAS unsigned* CCNT = (LAS unsigned*)(lds + L_CCNT); LAS unsigned* CAND = (LAS unsigned*)(lds + L_CAND);
    LAS unsigned short* SEG = (LAS unsigned short*)(lds + L_SEG); LAS unsigned* WCNT = (LAS unsigned*)(lds + L_WCNT);
    LAS unsigned short* IDX = (LAS unsigned short*)(lds + L_IDX);
    const size_t row0 = (size_t)b * S + t0;
    unsigned ky[4][16];
    {
        const bf16* IQ = (const bf16*)(ws + WS_IQ); const bf16* IKb = (const bf16*)(ws + WS_IK) + (size_t)b * S * 64 + (size_t)i16 * 64 + 16 * kg; const float* MS = (const float*)(ws + WS_MISC);
        f16x8 afr[4][2], alin[2]; float cl[4][4];
#pragma unroll
        for (int q = 0; q < 4; ++q) {
            const _Float16 wq = (_Float16)(MS[(row0 + q) * 40 + i16] * 0.03125f);
#pragma unroll
            for (int s = 0; s < 2; ++s) { const f16x8 x = *(const f16x8*)(IQ + (row0 + q) * 1024 + i16 * 64 + 16 * kg + 8 * s); afr[q][s] = x * wq; }
            const f32x4 tw = *(const f32x4*)(MS + (row0 + q) * 40 + 4 * kg);
#pragma unroll
            for (int r = 0; r < 4; ++r) cl[q][r] = tw[r] >= 0.f ? 0.5f : -0.5f; }
#pragma unroll
        for (int s = 0; s < 2; ++s) { const f16x8 x = *(const f16x8*)((const bf16*)(ws + WS_QS) + (row0 + (i16 & 3)) * 128 + ((i16 >> 2) & 1) * 64 + 16 * kg + 8 * s);
            alin[s] = i16 < 8 ? x : (f16x8){0, 0, 0, 0, 0, 0, 0, 0}; }
        const int na = ((t0 + 3) >> 6) + 1;
        f16x8 kbuf[4][2];
        const char* IKc = (const char*)(ws + WS_IK) + (size_t)b * S * 128 + (size_t)((lane >> 3) * 128 + (((lane & 7) ^ (lane >> 3)) * 16));
        const unsigned slot0 = (unsigned)(size_t)(lds + w * 16384);
        LAS const unsigned char* rdp0 = lds + w * 16384 + i16 * 128 + (((2 * kg) ^ (i16 & 7)) * 16);
        LAS const unsigned char* rdp1 = lds + w * 16384 + i16 * 128 + (((2 * kg + 1) ^ (i16 & 7)) * 16);
#define DSA_DMA(a_, sl_) do { const char* g_ = IKc + (size_t)(a_) * 8192; const unsigned l_ = slot0 + (unsigned)(sl_) * 8192u; \
            _Pragma("unroll") for (int j_ = 0; j_ < 8; ++j_) { unsigned keep_; \
                asm volatile("s_mov_b32 %0, m0\n\ts_mov_b32 m0, %2\n\ts_nop 0\n\tglobal_load_lds_dwordx4 %1, off\n\ts_mov_b32 m0, %0" \
                             : "=&s"(keep_) : "v"(g_ + j_ * 1024), "s"(l_ + (unsigned)j_ * 1024u) : "memory"); } } while (0)
#define DSA_RDK(sl_) do { _Pragma("unroll") for (int tl_ = 0; tl_ < 4; ++tl_) { \
            kbuf[tl_][0] = *(LAS const f16x8*)(rdp0 + (sl_) * 8192 + tl_ * 2048); kbuf[tl_][1] = *(LAS const f16x8*)(rdp1 + (sl_) * 8192 + tl_ * 2048); } } while (0)
        if (w < na) DSA_DMA(w, 0);
        if (w + 8 < na) DSA_DMA(w + 8, 1);
#pragma unroll
        for (int ap = 0; ap < 16; ++ap) {
            const int a = ap * 8 + w;
            if (PM == 10) { asm volatile("" :: "v"(afr[0][0]), "v"(afr[1][1]), "v"(afr[2][0]), "v"(afr[3][1]), "v"(cl[0][0]), "v"(cl[3][3]), "v"(kbuf[ap & 3][ap & 1]));
#pragma unroll
                for (int q = 0; q < 4; ++q) ky[q][ap] = KY_INV; }
            else if (a < na) {
                if (a + 8 < na) asm volatile("s_waitcnt vmcnt(8)" ::: "memory"); else asm volatile("s_waitcnt vmcnt(0)" ::: "memory");
                DSA_RDK(ap & 1);
                asm volatile("s_waitcnt lgkmcnt(0)" ::: "memory");
                if (a + 16 < na) DSA_DMA(a + 16, ap & 1);
                __builtin_amdgcn_sched_barrier(0);
                f32x4 lin[4];
#pragma unroll
                for (int qq = 0; qq < 4; qq += 2) {
                    f32x4 accs[2][4];
                    if (qq == 0) {
#pragma unroll
                        for (int tl = 0; tl < 4; ++tl) {
                            f32x4 acc = __builtin_amdgcn_mfma_f32_16x16x32_f16(alin[0], kbuf[tl][0], (f32x4){0.f, 0.f, 0.f, 0.f}, 0, 0, 0);
                            lin[tl] = __builtin_amdgcn_mfma_f32_16x16x32_f16(alin[1], kbuf[tl][1], acc, 0, 0, 0); } }
                    if constexpr (PM == 8 || PM == 9) {
#pragma unroll
                        for (int q2 = 0; q2 < 2; ++q2)
#pragma unroll
                            for (int tl = 0; tl < 4; ++tl) { const f32x4 kf = __builtin_bit_cast(f32x4, kbuf[tl][q2]); accs[q2][tl] = kf; }
                    } else {
#pragma unroll
                    for (int q2 = 0; q2 < 2; ++q2)
#pragma unroll
                        for (int tl = 0; tl < 4; ++tl) {
                            f32x4 acc = __builtin_amdgcn_mfma_f32_16x16x32_f16(afr[qq + q2][0], kbuf[tl][0], (f32x4){0.f, 0.f, 0.f, 0.f}, 0, 0, 0);
                            accs[q2][tl] = __builtin_amdgcn_mfma_f32_16x16x32_f16(afr[qq + q2][1], kbuf[tl][1], acc, 0, 0, 0); }
                    }
                    __builtin_amdgcn_sched_barrier(0);
                    if constexpr (PM == 7 || PM == 9) {
#pragma unroll
                        for (int q2 = 0; q2 < 2; ++q2) {
#pragma unroll
                            for (int tl = 0; tl < 4; ++tl) asm volatile("" :: "v"(accs[q2][tl]));
                            ky[qq + q2][ap] = KY_INV; }
                    } else {
#pragma unroll
                    for (int q2 = 0; q2 < 2; ++q2) { const int q = qq + q2;
                        float part[4];
#pragma unroll
                        for (int tl = 0; tl < 4; ++tl) { const f32x4 acc = accs[q2][tl];
                            part[tl] = __builtin_fmaf(__builtin_fabsf(acc[3]), cl[q][3], __builtin_fmaf(__builtin_fabsf(acc[2]), cl[q][2],
                                       __builtin_fmaf(__builtin_fabsf(acc[1]), cl[q][1], __builtin_fmaf(__builtin_fabsf(acc[0]), cl[q][0], lin[tl][q])))); }
                        const auto r01 = __builtin_amdgcn_permlane16_swap(__float_as_uint(part[0]), __float_as_uint(part[1]), false, false);
                        const auto r23 = __builtin_amdgcn_permlane16_swap(__float_as_uint(part[2]), __float_as_uint(part[3]), false, false);
                        const float t01 = __uint_as_float(r01[0]) + __uint_as_float(r01[1]), t23 = __uint_as_float(r23[0]) + __uint_as_float(r23[1]);
                        const auto rr_ = __builtin_amdgcn_permlane32_swap(__float_as_uint(t01), __float_as_uint(t23), false, false);
                        const float tot = __uint_as_float(rr_[0]) + __uint_as_float(rr_[1]);
                        const bool valid = (64 * a + lane) <= (t0 + q);
                        ky[q][ap] = valid ? __float_as_uint(tot) : KY_INV;
                    }
                    }
                    __builtin_amdgcn_sched_barrier(0);
                }
            } else {
#pragma unroll
                for (int q = 0; q < 4; ++q) ky[q][ap] = KY_INV;
            }
        }
#undef DSA_DMA
#undef DSA_RDK
    }
    DSA_BAR;
    *(LAS u32x4*)(lds + L_HIST + tid * 32) = (u32x4){0u, 0u, 0u, 0u}; *(LAS u32x4*)(lds + L_HIST + tid * 32 + 16) = (u32x4){0u, 0u, 0u, 0u};
    if (tid < 8) CCNT[tid] = 0u;
    if (dry == 2) {
#pragma unroll
        for (int q = 0; q < 4; ++q)
#pragma unroll
            for (int ap = 0; ap < 16; ++ap) asm volatile("" :: "v"(ky[q][ap]));
        DSA_BAR;
        return;
    }
#pragma unroll
    for (int q = 0; q < 4; ++q) { float mn = INFINITY, mx = -INFINITY;
#pragma unroll
        for (int ap = 0; ap < 16; ++ap) { const float v = __uint_as_float(ky[q][ap]); asm("v_max_f32 %0, %1, %2" : "=v"(mx) : "v"(mx), "v"(v)); asm("v_min_f32 %0, %1, %2" : "=v"(mn) : "v"(mn), "v"(v)); }
#pragma unroll
        for (int o = 1; o < 64; o <<= 1) { const float a_ = __shfl_xor(mn, o), b_ = __shfl_xor(mx, o); mn = a_ < mn ? a_ : mn; mx = b_ > mx ? b_ : mx; }
        if (lane == 0) { MM[(q * 8 + w) * 2] = __float_as_uint(mn); MM[(q * 8 + w) * 2 + 1] = __float_as_uint(mx); } }
    DSA_BAR;
    unsigned bn[4][8];
#pragma unroll
    for (int q = 0; q < 4; ++q) { float flo = INFINITY, fhi = -INFINITY;
#pragma unroll
        for (int j = 0; j < 8; ++j) { const float a_ = __uint_as_float(MM[(q * 8 + j) * 2]), b_ = __uint_as_float(MM[(q * 8 + j) * 2 + 1]); flo = a_ < flo ? a_ : flo; fhi = b_ > fhi ? b_ : fhi; }
        const float sc = (fhi > flo) ? 1023.0f / (fhi - flo) : 0.f;
#pragma unroll
        for (int ap = 0; ap < 16; ++ap) { const float v = __uint_as_float(ky[q][ap]); const bool ok = v == v; int bi = (int)((v - flo) * sc); bi = bi > 1023 ? 1023 : (bi < 0 ? 0 : bi);
            if (ok) lds_add(HIST + q * 1024 + bi, 1u);
            bi = ok ? bi : 0x7ff;
            if (ap & 1) bn[q][ap >> 1] |= (unsigned)bi << 16; else bn[q][ap >> 1] = (unsigned)bi; } }
    DSA_BAR;
    if (w < 4) { unsigned B, cab, cat; scan_hist32(HIST + w * 1024, 256u, lane, B, cab, cat); if (lane == 0) { THR[w * 8 + 0] = B; THR[w * 8 + 1] = cab; THR[w * 8 + 2] = cat; } }
    DSA_BAR;
    bool slow = false;
#pragma unroll
    for (int q = 0; q < 4; ++q) { const unsigned B = THR[q * 8 + 0]; slow = slow || (THR[q * 8 + 2] > (unsigned)CAP);
#pragma unroll
        for (int ap = 0; ap < 16; ++ap) { const unsigned bi = (ap & 1) ? (bn[q][ap >> 1] >> 16) : (bn[q][ap >> 1] & 0xffffu);
            if (bi == B) { const unsigned slot = __hip_atomic_fetch_add(CCNT + q, 1u, __ATOMIC_RELAXED, __HIP_MEMORY_SCOPE_WORKGROUP); if (slot < (unsigned)CAP) CAND[q * CAP + slot] = kykey(ky[q][ap]); } } }
    DSA_BAR;
    if (!slow) {
        if (w < 4) {
            const unsigned n = THR[w * 8 + 2], need = 256u - THR[w * 8 + 1];
            unsigned myk[4], cg[4], ce[4];
#pragma unroll
            for (int k = 0; k < 4; ++k) { const unsigned i = (unsigned)lane + 64u * k; myk[k] = i < n ? CAND[w * CAP + i] : 0u; cg[k] = 0u; ce[k] = 0u; }
            for (unsigned j = 0; j < n; ++j) { const unsigned cj = CAND[w * CAP + j];
#pragma unroll
                for (int k = 0; k < 4; ++k) { cg[k] += cj > myk[k] ? 1u : 0u; ce[k] += cj == myk[k] ? 1u : 0u; } }
            unsigned Ktv = 0u, rv = 0u, cev = 0u;
#pragma unroll
            for (int k = 0; k < 4; ++k) { const bool ok = ((unsigned)lane + 64u * k < n) && cg[k] < need && need <= cg[k] + ce[k];
                const unsigned long long bm = __ballot(ok);
                if (bm) { const int L = __ffsll((long long)bm) - 1; Ktv = (unsigned)__builtin_amdgcn_readlane((int)myk[k], L); rv = need - (unsigned)__builtin_amdgcn_readlane((int)cg[k], L); cev = (unsigned)__builtin_amdgcn_readlane((int)ce[k], L); } }
            if (lane == 0) { THR[w * 8 + 4] = Ktv; THR[w * 8 + 5] = rv; THR[w * 8 + 6] = 256u - rv; THR[w * 8 + 7] = (cev == rv) ? 0u : 1u; }
        }
    } else {
        for (int o = tid * 16; o < 65536; o += NTHR * 16) *(LAS u32x4*)(lds + L_H1 + o) = (u32x4){0u, 0u, 0u, 0u};
        if (tid < 128) *(LAS u32x4*)(lds + L_H3 + tid * 16) = (u32x4){0u, 0u, 0u, 0u};
        if (tid < 4) THR[tid * 8 + 7] = 1u;
        DSA_BAR;
#pragma unroll
        for (int q = 0; q < 4; ++q)
#pragma unroll
            for (int ap = 0; ap < 16; ++ap) { const unsigned k = kykey(ky[q][ap]); if (k) lds_add(H1 + q * 2048 + (k >> 21), 1u << (((k >> 20) & 1u) * 16)); }
        DSA_BAR;
        if (w < 4) { unsigned T1, c1; { unsigned ct_; scan_hist<32>(H1 + w * 2048, 256u, lane, T1, c1, ct_); } if (lane == 0) { THR[w * 8 + 0] = T1; THR[w * 8 + 1] = c1; } }
        DSA_BAR;
        unsigned T1v[4];
#pragma unroll
        for (int q = 0; q < 4; ++q) T1v[q] = THR[q * 8 + 0];
#pragma unroll
        for (int q = 0; q < 4; ++q)
#pragma unroll
            for (int ap = 0; ap < 16; ++ap) { const unsigned k = kykey(ky[q][ap]); if ((k >> 20) == T1v[q]) { const unsigned b2 = (k >> 8) & 0xfffu; lds_add(H2 + q * 2048 + (b2 >> 1), 1u << ((b2 & 1u) * 16)); } }
        DSA_BAR;
        if (w < 4) { unsigned T2, c2; const unsigned need2 = 256u - THR[w * 8 + 1]; { unsigned ct_; scan_hist<32>(H2 + w * 2048, need2, lane, T2, c2, ct_); } if (lane == 0) { THR[w * 8 + 2] = T2; THR[w * 8 + 3] = c2; } }
        DSA_BAR;
        unsigned P2v[4];
#pragma unroll
        for (int q = 0; q < 4; ++q) P2v[q] = (T1v[q] << 12) | THR[q * 8 + 2];
#pragma unroll
        for (int q = 0; q < 4; ++q)
#pragma unroll
            for (int ap = 0; ap < 16; ++ap) { const unsigned k = kykey(ky[q][ap]); if ((k >> 8) == P2v[q]) { const unsigned b3 = k & 0xffu; lds_add(H3 + q * 128 + (b3 >> 1), 1u << ((b3 & 1u) * 16)); } }
        DSA_BAR;
        if (w < 4) { unsigned T3, c3; const unsigned need3 = 256u - THR[w * 8 + 1] - THR[w * 8 + 3]; { unsigned ct_; scan_hist<2>(H3 + w * 128, need3, lane, T3, c3, ct_); }
            if (lane == 0) { const unsigned r = need3 - c3; THR[w * 8 + 4] = (((THR[w * 8 + 0] << 12) | THR[w * 8 + 2]) << 8) | T3; THR[w * 8 + 5] = r; THR[w * 8 + 6] = 256u - r; } }
        DSA_BAR;
    }
    DSA_BAR;
    const bool ties = (THR[7] | THR[15] | THR[23] | THR[31]) != 0u;
    if (!ties) {
#pragma unroll
        for (int q = 0; q < 4; ++q) { float Ktq = key2f(THR[q * 8 + 4]); asm volatile("" : "+v"(Ktq)); unsigned base = 0u; LAS unsigned short* sg = SEG + (q * 8 + w) * 256;
#pragma unroll
            for (int ap = 0; ap < 16; ++ap) { const bool sel = __uint_as_float(ky[q][ap]) >= Ktq; const unsigned long long m = __ballot(sel);
                if (sel) sg[base + (unsigned)__popcll(m & ((1ull << lane) - 1ull))] = (unsigned short)(64 * (ap * 8 + w) + lane);
                base += (unsigned)__popcll(m); }
            if (lane == 0) WCNT[q * 8 + w] = base; }
        DSA_BAR;
        if (!dry || dry == 3) { unsigned short* G = (unsigned short*)(ws + WS_GIDX) + row0 * 256;
#pragma unroll
            for (int h = 0; h < 2; ++h) { const int e = tid + h * NTHR, q = e >> 8, pos = e & 255; unsigned off = 0u; int wv = 0; unsigned src = 0u;
#pragma unroll
                for (int j = 0; j < 8; ++j) { const unsigned c = WCNT[q * 8 + j]; if ((unsigned)pos >= off && (unsigned)pos < off + c) { wv = j; src = (unsigned)pos - off; } off += c; }
                G[(size_t)q * 256 + pos] = SEG[(q * 8 + wv) * 256 + src]; } }
    } else {
        unsigned Kt[4], rr[4], ngt[4];
#pragma unroll
        for (int q = 0; q < 4; ++q) { Kt[q] = THR[q * 8 + 4]; rr[q] = THR[q * 8 + 5]; ngt[q] = THR[q * 8 + 6]; }
        { unsigned myv = 0u;
#pragma unroll
          for (int q = 0; q < 4; ++q)
#pragma unroll
              for (int ap = 0; ap < 16; ++ap) { const unsigned k = kykey(ky[q][ap]);
                  const unsigned cg = (unsigned)__popcll(__ballot(k > Kt[q])), ce = (unsigned)__popcll(__ballot(k == Kt[q]));
                  if (lane == q * 16 + ap) myv = cg | (ce << 16); __builtin_amdgcn_sched_barrier(0); }
          CNT[(lane >> 4) * 128 + (lane & 15) * 8 + w] = myv; }
        DSA_BAR;
#pragma unroll
        for (int q = 0; q < 4; ++q) {
            const u32x2 cv = *(const LAS u32x2*)(CNT + q * 128 + 2 * lane);
            const unsigned sum = cv.x + cv.y; unsigned incl = sum;
#pragma unroll
            for (int o = 1; o < 64; o <<= 1) { const unsigned v = __shfl_up(incl, o); if (lane >= o) incl += v; }
            const unsigned excl = incl - sum;
            const int pv_ = (int)((w & 1) ? excl + cv.x : excl);
            unsigned Ktq = Kt[q]; asm volatile("" : "+v"(Ktq));
#pragma unroll
            for (int ap = 0; ap < 16; ++ap) {
                const int a = ap * 8 + w;
                const unsigned P = (unsigned)__builtin_amdgcn_readlane(pv_, a >> 1);
                const unsigned k = kykey(ky[q][ap]);
                const bool isg = k > Ktq, ise = k == Ktq;
                const unsigned long long mg = __ballot(isg), me = __ballot(ise), lower = (1ull << lane) - 1ull;
                const unsigned posg = (P & 0xffffu) + (unsigned)__popcll(mg & lower), rank = (P >> 16) + (unsigned)__popcll(me & lower);
                if (isg) IDX[q * 256 + posg] = (unsigned short)(64 * a + lane);
                else if (ise && rank < rr[q]) IDX[q * 256 + ngt[q] + rank] = (unsigned short)(64 * a + lane);
                __builtin_amdgcn_sched_barrier(0);
            }
        }
    DSA_BAR;
        if (!dry || dry == 3) { if (tid < 128) { const int q = tid >> 5, part = tid & 31;
            *(u32x4*)((unsigned short*)(ws + WS_GIDX) + (row0 + q) * 256 + part * 8) = *(const LAS u32x4*)(IDX + q * 256 + part * 8); } }
    }
    DSA_BAR;
}

__device__ __forceinline__ void dsa_attn_item(unsigned char* ws, LAS unsigned char* ldw, const int b, const int g, const int t, const int lane_in, const int dry, u32x2& idxreg, const int nb, const int ng, const int nt) {
    int lane = lane_in; asm volatile("" : "+v"(lane));
    const int i16 = lane & 15, kg = lane >> 4;
    const int nsel = (t + 1) < 256 ? (t + 1) : 256;
    const size_t row = (size_t)b * S + t;
    LAS unsigned short* idx = (LAS unsigned short*)ldw; LAS unsigned char* vst = ldw + 512;
    if (t >= 256) *(LAS u32x2*)(idx + 4 * lane) = idxreg;
    else { const unsigned i0 = 4u * (unsigned)lane; *(LAS u32x2*)(idx + 4 * lane) = (u32x2){i0 | ((i0 + 1u) << 16), (i0 + 2u) | ((i0 + 3u) << 16)}; }
    if (nt >= 256) idxreg = *(const u32x2*)((const unsigned short*)(ws + WS_GIDX) + ((size_t)nb * S + nt) * 256 + 4 * lane);
    (void)ng;
    const int hh = 4 * g + (i16 & 3);
    const bf16* DQp = (const bf16*)(ws + WS_DQ) + row * 1024 + hh * 128 + 16 * kg;
    bf16x8 bq[4];
#pragma unroll
    for (int s = 0; s < 4; ++s) bq[s] = *(const bf16x8*)(DQp + 64 * (s >> 1) + 8 * (s & 1));
    const bf16* DKb = (const bf16*)(ws + WS_DK) + (size_t)b * S * 256 + g * 128 + 8 * i16;
    LAS unsigned char* kwr = ldw + 512 + VST_W + (4 * kg) * KROW + 16 * i16;
    const LAS unsigned char* krd = ldw + 512 + VST_W + i16 * KROW + 32 * kg;
    const bf16* DVb = (const bf16*)(ws + WS_DV) + (size_t)b * S * 256 + g * 128 + 8 * i16;
    const float slope2 = __builtin_amdgcn_exp2f(-(float)(hh + 1)) * LOG2E;
    const int qd = i16 >> 2, pp = i16 & 3;
    const LAS unsigned char* vrd = vst + (4 * kg + qd) * VROW + 8 * pp;
    bf16x8 kb[4][4]; u32x4 va[8], vb2[8];
#define DSA_LOADKT(slot_, T_) do { const u16x4 k4_ = *(const LAS u16x4*)(idx + 16 * (T_) + 4 * kg); \
        _Pragma("unroll") for (int i_ = 0; i_ < 4; ++i_) { const int kidx_ = (int)k4_[i_];     \
            kb[slot_][i_] = *(const bf16x8*)(DKb + (size_t)kidx_ * 256); } } while (0)
#define DSA_LOADVH(dst_, u_) do { int raw_[8]; _Pragma("unroll") for (int i_ = 0; i_ < 8; ++i_) raw_[i_] = (int)idx[32 * (u_) + 4 * i_ + kg];     \
        _Pragma("unroll") for (int i_ = 0; i_ < 8; ++i_) { const int li_ = 32 * (u_) + 4 * i_ + kg; const int kidx_ = (li_ < nsel) ? raw_[i_] : 0; \
        dst_[i_] = *(const u32x4*)(DVb + (size_t)kidx_ * 256); } } while (0)
    asm volatile("s_waitcnt lgkmcnt(0)" ::: "memory");
    if (dry != 5) {
#pragma unroll
    for (int Tt = 0; Tt < 4; ++Tt) DSA_LOADKT(Tt, Tt);
    }
    DSA_LOADVH(va, 0);
    f32x4 st[16];
#pragma unroll
    for (int Tt = 0; Tt < 16; ++Tt) { f32x4 acc = (f32x4){0.f, 0.f, 0.f, 0.f};
        if (dry != 5) {
#pragma unroll
        for (int i = 0; i < 4; ++i) *(LAS bf16x8*)(kwr + i * KROW) = kb[Tt & 3][i];
        bf16x8 kf[4];
#pragma unroll
        for (int s = 0; s < 4; ++s) kf[s] = *(const LAS bf16x8*)(krd + 128 * (s >> 1) + 16 * (s & 1));
#pragma unroll
        for (int s = 0; s < 4; ++s) acc = __builtin_amdgcn_mfma_f32_16x16x32_bf16(kf[s], bq[s], acc, 0, 0, 0);
        }
        st[Tt] = acc;
        if (Tt + 4 < 16 && dry != 5) DSA_LOADKT(Tt & 3, Tt + 4); }
    DSA_LOADVH(vb2, 1);
    float mx = -1e30f;
#pragma unroll
    for (int Tt = 0; Tt < 16; ++Tt) { const u16x4 kp4 = *(const LAS u16x4*)(idx + 16 * Tt + 4 * kg);
#pragma unroll
        for (int r = 0; r < 4; ++r) { const int li = 16 * Tt + 4 * kg + r; float v = st[Tt][r] - slope2 * (float)(t - (int)kp4[r]); v = (li < nsel) ? v : -1e30f; st[Tt][r] = v; mx = fmaxf(mx, v); } }
    mx = fmaxf(mx, __shfl_xor(mx, 16)); mx = fmaxf(mx, __shfl_xor(mx, 32));
    float l_run = 0.f;
#pragma unroll
    for (int Tt = 0; Tt < 16; ++Tt)
#pragma unroll
        for (int r = 0; r < 4; ++r) { const float p = __builtin_amdgcn_exp2f(st[Tt][r] - mx); st[Tt][r] = p; l_run += p; }
    if (dry == 4) {
#pragma unroll
        for (int Tt = 0; Tt < 16; ++Tt) asm volatile("" :: "v"(st[Tt]));
#pragma unroll
        for (int i = 0; i < 8; ++i) { asm volatile("" :: "v"(va[i])); asm volatile("" :: "v"(vb2[i])); }
        asm volatile("" :: "v"(l_run));
        return;
    }
    f32x4 o[8];
#pragma unroll
    for (int n = 0; n < 8; ++n) o[n] = (f32x4){0.f, 0.f, 0.f, 0.f};
#pragma unroll
    for (int u = 0; u < 8; ++u) {
        if (u & 1) {
#pragma unroll
            for (int i = 0; i < 8; ++i) *(LAS u32x4*)(vst + (4 * i + kg) * VROW + i16 * 16) = vb2[i];
            if (u + 2 < 8) DSA_LOADVH(vb2, u + 2);
        } else {
#pragma unroll
            for (int i = 0; i < 8; ++i) *(LAS u32x4*)(vst + (4 * i + kg) * VROW + i16 * 16) = va[i];
            if (u + 2 < 8) DSA_LOADVH(va, u + 2);
        }
        const u32x4 pw = (u32x4){cvt_pk_bf16(st[2 * u][0], st[2 * u][1]), cvt_pk_bf16(st[2 * u][2], st[2 * u][3]), cvt_pk_bf16(st[2 * u + 1][0], st[2 * u + 1][1]), cvt_pk_bf16(st[2 * u + 1][2], st[2 * u + 1][3])};
        const bf16x8 pa = __builtin_bit_cast(bf16x8, pw);
        asm volatile("s_waitcnt lgkmcnt(0)" ::: "memory");
#pragma unroll
        for (int n = 0; n < 8; ++n) {
            const s16x4 lo_ = __builtin_bit_cast(s16x4, __builtin_amdgcn_ds_read_tr16_b64_v4i16((LAS s16x4*)(vrd + 32 * n)));
            const s16x4 hi_ = __builtin_bit_cast(s16x4, __builtin_amdgcn_ds_read_tr16_b64_v4i16((LAS s16x4*)(vrd + 32 * n + 16 * VROW)));
            const bf16x8 vf = (bf16x8){lo_[0], lo_[1], lo_[2], lo_[3], hi_[0], hi_[1], hi_[2], hi_[3]};
            o[n] = __builtin_amdgcn_mfma_f32_16x16x32_bf16(pa, vf, o[n], 0, 0, 0); }
        asm volatile("s_waitcnt lgkmcnt(0)" ::: "memory");
    }
#undef DSA_LOADKT
#undef DSA_LOADVH
    l_run += __shfl_xor(l_run, 16); l_run += __shfl_xor(l_run, 32);
    const float lsel = __shfl(l_run, kg);
    const float inv = __builtin_amdgcn_rcpf(lsel);
    const bf16* DZ = (const bf16*)(ws + WS_DZ); bf16* OD = (bf16*)(ws + WS_DQ);
    const size_t ob = row * 1024 + (size_t)(4 * g + kg) * 128 + 8 * i16;
    const u32x4 zw = *(const u32x4*)(DZ + ob);
    LAS float* ost = (LAS float*)vst + kg * 132;
#pragma unroll
    for (int n = 0; n < 8; ++n) { const float ov = kg == 0 ? o[n][0] : kg == 1 ? o[n][1] : kg == 2 ? o[n][2] : o[n][3]; ost[16 * n + i16] = ov * inv; }
    asm volatile("s_waitcnt lgkmcnt(0)" ::: "memory");
    const f32x4 o0 = *(const LAS f32x4*)(ost + 8 * i16), o1 = *(const LAS f32x4*)(ost + 8 * i16 + 4);
    f32x4 z0, z1; unpack8(zw, z0, z1);
    const u32x4 pk = pack8(o0 * z0, o1 * z1);
    if (!dry) *(u32x4*)(OD + ob) = pk; else asm volatile("" :: "v"(pk));
    asm volatile("s_waitcnt lgkmcnt(0)" ::: "memory");
}

template <int PM>
__device__ __forceinline__ void dsa_phaseA(unsigned char* ws, LAS unsigned char* lds, int c, int G, int lane, int w, int dry) {
    for (int it = 0; it < 16; ++it) {
        const int b = it & 1, k = it >> 1;
        for (int cc = c; cc < 256; cc += G) { const int ti = 256 * k + ((k & 1) ? 255 - cc : cc);
            int nrow = -1;
            if (cc + G >= 256 && it + 1 < 16) { const int k2 = (it + 1) >> 1, ti2 = 256 * k2 + ((k2 & 1) ? 255 - c : c); if (ti2 >= 64) nrow = ((it + 1) & 1) * S + 4 * ti2; }
            if (ti >= 64) dsa_select_tile<PM>(ws, lds, b, 4 * ti, lane, w, dry, nrow); }
    }
}
__device__ __forceinline__ void dsa_phaseB(unsigned char* ws, LAS unsigned char* lds, int vcu, int G, int lane, int w, int dry) {
    LAS unsigned char* ldw = lds + w * LB_WAVE;
    unsigned* heads = (unsigned*)(ws + WS_CTL) + CW_Q0 + (dry ? 8 * 64 : 0);
    const int myshard = (G == 256) ? (vcu >> 5) : (vcu & 7);
    for (int round = 0; round < 8; ++round) { const int sh = (myshard + round) & 7;
        for (;;) { unsigned base = 0u; if (lane == 0) base = __hip_atomic_fetch_add(heads + sh * 64, (unsigned)DSA_BATCH, __ATOMIC_RELAXED, __HIP_MEMORY_SCOPE_AGENT);
            base = (unsigned)__builtin_amdgcn_readfirstlane((int)base); if (base >= 4096u) break;
            const int it0 = sh * 4096 + (int)base; u32x2 idxreg = (u32x2){0u, 0u};
            if ((it0 & (S - 1)) >= 256) idxreg = *(const u32x2*)((const unsigned short*)(ws + WS_GIDX) + ((size_t)(it0 >> 14) * S + (it0 & (S - 1))) * 256 + 4 * lane);
            for (int k = 0; k < DSA_BATCH; ++k) { const int item = it0 + k, nxt = (k < DSA_BATCH - 1) ? item + 1 : -1;
                dsa_attn_item(ws, ldw, item >> 14, (item >> 13) & 1, item & (S - 1), lane, dry, idxreg, nxt >> 14, (nxt >> 13) & 1, nxt < 0 ? 0 : (nxt & (S - 1))); } } }
}
}

namespace nsa {
typedef short s16x4 __attribute__((ext_vector_type(4)));
constexpr int L_K = 0, L_V = 32768, L_IMP = 65536, IMP_LD = 132, L_SELM = L_IMP + 64 * IMP_LD * 4, L_WS = L_SELM + 1024, L_END = L_WS + 2048;
static_assert(L_END <= 131072, "nsa LDS map");
#define NSA_KSWZ(row, colB) ((row) * 256 + ((colB) ^ (((row) & 7) << 4)))
#define NSA_SBAR() __builtin_amdgcn_sched_barrier(0)
__device__ __forceinline__ int crow(int r, int hi) { return (r & 3) + 8 * (r >> 2) + 4 * hi; }
__device__ __forceinline__ int v_st(int k, int c) { const int kk = (k & ~0xC) | ((k & 4) << 1) | ((k & 8) >> 1); return ((kk >> 3) * 4 + (c >> 5)) * 512 + ((kk & 7) * 32 + (c & 31)) * 2; }
__device__ __forceinline__ int v_rd_base(int lane) { return ((lane & 3) << 3) | (((lane >> 2) & 3) << 6) | (((lane >> 4) & 1) << 5) | (((lane >> 5) & 1) << 8); }
constexpr int v_rd_off(int d0, int ks, int half) { return d0 * 512 + ks * 4096 + half * 2048; }
template <int OFF> __device__ __forceinline__ s16x4 tr_read(int vb) { s16x4 r; asm volatile("ds_read_b64_tr_b16 %0, %1 offset:%2" : "=&v"(r) : "v"(vb), "i"(OFF) : "memory"); return r; }
template <int D0> __device__ __forceinline__ void pv_one(f32x16& od, int vb, bf16x8 pa0, bf16x8 pa1, bf16x8 pa2, bf16x8 pa3) {
    const s16x4 l0 = tr_read<v_rd_off(D0, 0, 0)>(vb), h0 = tr_read<v_rd_off(D0, 0, 1)>(vb), l1 = tr_read<v_rd_off(D0, 1, 0)>(vb), h1 = tr_read<v_rd_off(D0, 1, 1)>(vb);
    const s16x4 l2 = tr_read<v_rd_off(D0, 2, 0)>(vb), h2 = tr_read<v_rd_off(D0, 2, 1)>(vb), l3 = tr_read<v_rd_off(D0, 3, 0)>(vb), h3 = tr_read<v_rd_off(D0, 3, 1)>(vb);
    asm volatile("s_waitcnt lgkmcnt(0)" ::: "memory"); NSA_SBAR();
#define NSA_PK(L, H) (bf16x8){L[0], L[1], L[2], L[3], H[0], H[1], H[2], H[3]}
    od = __builtin_amdgcn_mfma_f32_32x32x16_bf16(pa0, NSA_PK(l0, h0), od, 0, 0, 0);
    od = __builtin_amdgcn_mfma_f32_32x32x16_bf16(pa1, NSA_PK(l1, h1), od, 0, 0, 0);
    od = __builtin_amdgcn_mfma_f32_32x32x16_bf16(pa2, NSA_PK(l2, h2), od, 0, 0, 0);
    od = __builtin_amdgcn_mfma_f32_32x32x16_bf16(pa3, NSA_PK(l3, h3), od, 0, 0, 0);
#undef NSA_PK
}
__device__ __forceinline__ void pv_all(f32x16* o, int vb, bf16x8 pa0, bf16x8 pa1, bf16x8 pa2, bf16x8 pa3) {
    pv_one<0>(o[0], vb, pa0, pa1, pa2, pa3); pv_one<1>(o[1], vb, pa0, pa1, pa2, pa3); pv_one<2>(o[2], vb, pa0, pa1, pa2, pa3); pv_one<3>(o[3], vb, pa0, pa1, pa2, pa3);
}
__device__ __forceinline__ void qkt(f32x16& p0, f32x16& p1, const LAS unsigned char* Ks, const bf16x8* qr, int r32, int hi) {
    p0 = f32x16{}; p1 = f32x16{};
#pragma unroll
    for (int d0 = 0; d0 < 8; ++d0) { const int cb = (d0 * 16 + hi * 8) * 2;
        const bf16x8 b0 = *(const LAS bf16x8*)(Ks + NSA_KSWZ(r32, cb));
        const bf16x8 b1 = *(const LAS bf16x8*)(Ks + NSA_KSWZ(32 + r32, cb));
        p0 = __builtin_amdgcn_mfma_f32_32x32x16_bf16(b0, qr[d0], p0, 0, 0, 0);
        p1 = __builtin_amdgcn_mfma_f32_32x32x16_bf16(b1, qr[d0], p1, 0, 0, 0); }
}
__device__ __forceinline__ void pack_p(const f32x16& p0, const f32x16& p1, bf16x8& pa0, bf16x8& pa1, bf16x8& pa2, bf16x8& pa3) {
#define NSA_PK4(P, BASE, OUT) do { const unsigned a0 = cvt_pk_bf16(P[BASE + 0], P[BASE + 1]), a1 = cvt_pk_bf16(P[BASE + 2], P[BASE + 3]);   \
    const unsigned b0 = cvt_pk_bf16(P[BASE + 4], P[BASE + 5]), b1 = cvt_pk_bf16(P[BASE + 6], P[BASE + 7]);                              \
    const auto r0 = __builtin_amdgcn_permlane32_swap(a0, b0, false, false); const auto r1 = __builtin_amdgcn_permlane32_swap(a1, b1, false, false); \
    const u32x4 w_ = {r0[0], r1[0], r0[1], r1[1]}; OUT = __builtin_bit_cast(bf16x8, w_); } while (0)
    NSA_PK4(p0, 0, pa0); NSA_PK4(p0, 8, pa1); NSA_PK4(p1, 0, pa2); NSA_PK4(p1, 8, pa3);
#undef NSA_PK4
}
__device__ __forceinline__ float row_max(const f32x16& p0, const f32x16& p1) {
    float m = p0[0];
#pragma unroll
    for (int r = 1; r < 16; ++r) m = fmaxf(m, p0[r]);
#pragma unroll
    for (int r = 0; r < 16; ++r) m = fmaxf(m, p1[r]);
    const auto rr = __builtin_amdgcn_permlane32_swap(__float_as_uint(m), __float_as_uint(m), false, false);
    return fmaxf(__uint_as_float(rr[0]), __uint_as_float(rr[1]));
}
__device__ __forceinline__ float row_sum(const f32x16& p0, const f32x16& p1) {
    float s = 0.f;
#pragma unroll
    for (int r = 0; r < 16; ++r) s += p0[r];
#pragma unroll
    for (int r = 0; r < 16; ++r) s += p1[r];
    const auto rr = __builtin_amdgcn_permlane32_swap(__float_as_uint(s), __float_as_uint(s), false, false);
    return __uint_as_float(rr[0]) + __uint_as_float(rr[1]);
}
__device__ __forceinline__ int next_bit(unsigned long long lo, unsigned long long hi, int from) {
    if (from < 64) { const unsigned long long v = lo >> from; if (v) return from + (__ffsll((long long)v) - 1); from = 64; }
    if (from < 128) { const unsigned long long v = hi >> (from - 64); if (v) return from + (__ffsll((long long)v) - 1); }
    return -1;
}

struct Stg { u32x4 k0, k1, v0, v1; };

__device__ __forceinline__ void nsa_unit(unsigned char* ws, LAS unsigned char* lds, const int b, const int g, const int qb, const int tid_in, const int lane_in, const int w_in, const int dry) {
    int w = w_in; asm volatile("" : "+s"(w));
    int lane = lane_in; asm volatile("" : "+v"(lane));
    const int tid = w * 64 + lane; (void)tid_in;
    const int r32 = lane & 31, hi = lane >> 5, ql = r32 >> 2, j = r32 & 3, h = 4 * g + j;
    const int toff = 8 * w + ql, tq = 64 * qb + toff;
    const size_t row = (size_t)b * S + tq;
    const int bg = b * 2 + g;
    LAS float* IMP = (LAS float*)(lds + L_IMP); LAS unsigned* SELM = (LAS unsigned*)(lds + L_SELM);
    LAS float* wsf = (LAS float*)(lds + L_WS) + w * 64;
    const float slope2 = __builtin_amdgcn_exp2f(-(float)(h + 1)) * LOG2E;
    bf16x8 qr[8];
    { const bf16* Qp = (const bf16*)(ws + WS_QN) + row * 1024 + h * 128 + hi * 8;
#pragma unroll
      for (int d0 = 0; d0 < 8; ++d0) qr[d0] = *(const bf16x8*)(Qp + d0 * 16); }
    const int sr = tid >> 4, sc = (tid & 15) * 8;
    const int vst0 = v_st(sr, sc), vst1 = v_st(32 + sr, sc), kst0 = NSA_KSWZ(sr, sc * 2), kst1 = NSA_KSWZ(32 + sr, sc * 2);
    const int vb0 = (int)(uintptr_t)(lds + L_V) + v_rd_base(lane);
    float* ACCw = (float*)(ws + WS_XB) + ((size_t)((bg * 128 + qb) * 8 + w)) * 4096 + lane;
    const float* MS = (const float*)(ws + WS_MISC);
    const size_t obase = ((size_t)b * S + 64 * qb + 8 * w + hi) * 1024 + (size_t)(4 * g) * 128 + r32;
    const size_t gbase = ((size_t)b * S + 64 * qb + 8 * w + hi) * 40 + 16 + (size_t)(4 * g) * 3;

    for (int i = tid; i < 64 * IMP_LD; i += NTHR) IMP[i] = 0.f;

    Stg st;
#define NSA_SLOAD(KP, VP) do { const bf16* kp_ = (KP); const bf16* vp_ = (VP); \
        st.k0 = *(const u32x4*)(kp_ + (size_t)sr * 128 + sc); st.k1 = *(const u32x4*)(kp_ + (size_t)(32 + sr) * 128 + sc); \
        st.v0 = *(const u32x4*)(vp_ + (size_t)sr * 128 + sc); st.v1 = *(const u32x4*)(vp_ + (size_t)(32 + sr) * 128 + sc); } while (0)
#define NSA_SWRITE(bufi) do { LAS unsigned char* kb_ = lds + L_K + (bufi) * 16384; LAS unsigned char* vb_ = lds + L_V + (bufi) * 16384; \
        *(LAS u32x4*)(kb_ + kst0) = st.k0; *(LAS u32x4*)(kb_ + kst1) = st.k1; *(LAS u32x4*)(vb_ + vst0) = st.v0; *(LAS u32x4*)(vb_ + vst1) = st.v1; } while (0)
#define NSA_MASK(P0, P1, LO, HI, SL, SB) do { int lo_ = (LO), hi_ = (HI); float sl_ = (SL), sb_ = (SB); asm volatile("" : "+v"(lo_), "+v"(hi_), "+v"(sl_), "+v"(sb_)); \
        if (__all(lo_ < 0 && hi_ >= 59)) {                   \
            _Pragma("unroll") for (int r_ = 0; r_ < 16; ++r_) { const int c0_ = (r_ & 3) + 8 * (r_ >> 2), c1_ = c0_ + 32; \
                P0[r_] = P0[r_] + fmaf(sl_, (float)c0_, sb_); P1[r_] = P1[r_] + fmaf(sl_, (float)c1_, sb_); } \
        } else { \
        _Pragma("unroll") for (int r_ = 0; r_ < 16; ++r_) { const int c0_ = (r_ & 3) + 8 * (r_ >> 2), c1_ = c0_ + 32; \
            P0[r_] = (c0_ > lo_ && c0_ <= hi_) ? P0[r_] + fmaf(sl_, (float)c0_, sb_) : -INFINITY; \
            P1[r_] = (c1_ > lo_ && c1_ <= hi_) ? P1[r_] + fmaf(sl_, (float)c1_, sb_) : -INFINITY; } } } while (0)
#define NSA_ONLINE(P0, P1) do { const float pm_ = row_max(P0, P1); const float mn_ = (pm_ > m_run + 8.0f) ? pm_ : m_run; const float al_ = __builtin_amdgcn_exp2f(m_run - mn_); m_run = mn_; \
        _Pragma("unroll") for (int r_ = 0; r_ < 16; ++r_) { P0[r_] = __builtin_amdgcn_exp2f(P0[r_] - mn_); P1[r_] = __builtin_amdgcn_exp2f(P1[r_] - mn_); } \
        l_run = l_run * al_ + row_sum(P0, P1); \
        if (__any(al_ < 1.f)) { if (hi == 0) wsf[r32] = al_; asm volatile("s_waitcnt lgkmcnt(0)" ::: "memory"); \
            _Pragma("unroll") for (int r_ = 0; r_ < 16; ++r_) { const float f_ = wsf[crow(r_, hi)]; o[0][r_] *= f_; o[1][r_] *= f_; o[2][r_] *= f_; o[3][r_] *= f_; } } } while (0)

    f32x16 o[4]; f32x16 p0, p1; bf16x8 pa0, pa1, pa2, pa3;
    float m_run, l_run;

    const bf16* KCp = (const bf16*)(ws + WS_KC) + (size_t)bg * 512 * 128; const bf16* VCp = (const bf16*)(ws + WS_VC) + (size_t)bg * 512 * 128;
    const int ntc = ((4 * qb + 2) >> 6) + 1;
    const int nmax = (tq - 31) >> 4;
    const float tqc = (float)tq - 15.5f;
    m_run = -1e30f; l_run = 0.f;
    NSA_SLOAD(KCp, VCp); __syncthreads(); NSA_SWRITE(0); __syncthreads();
    for (int tc = 0; tc < ntc; ++tc) {
        if (tc + 1 < ntc) NSA_SLOAD(KCp + (size_t)(tc + 1) * 64 * 128, VCp + (size_t)(tc + 1) * 64 * 128);
        qkt(p0, p1, lds + L_K + (tc & 1) * 16384, qr, r32, hi);
        NSA_MASK(p0, p1, -1, nmax - 64 * tc - 4 * hi, 16.f * slope2, slope2 * ((float)(16 * (64 * tc + 4 * hi)) - tqc));
        { const float pm = row_max(p0, p1); const float mn = fmaxf(m_run, pm); const float al = __builtin_amdgcn_exp2f(m_run - mn); m_run = mn;
#pragma unroll
          for (int r = 0; r < 16; ++r) { p0[r] = __builtin_amdgcn_exp2f(p0[r] - mn); p1[r] = __builtin_amdgcn_exp2f(p1[r] - mn); }
          l_run = l_run * al + row_sum(p0, p1); }
        if (tc + 1 < ntc) NSA_SWRITE((tc + 1) & 1);
        __syncthreads();
    }
    {
        const float invl = l_run > 0.f ? 1.0f / l_run : 0.f;
#pragma unroll
        for (int d = 0; d < 4; ++d) o[d] = f32x16{};
        NSA_SLOAD(KCp, VCp); NSA_SWRITE(0); __syncthreads();
        for (int tc = 0; tc < ntc; ++tc) {
            if (tc + 1 < ntc) NSA_SLOAD(KCp + (size_t)(tc + 1) * 64 * 128, VCp + (size_t)(tc + 1) * 64 * 128);
            qkt(p0, p1, lds + L_K + (tc & 1) * 16384, qr, r32, hi);
            NSA_MASK(p0, p1, -1, nmax - 64 * tc - 4 * hi, 16.f * slope2, slope2 * ((float)(16 * (64 * tc + 4 * hi)) - tqc));
#pragma unroll
            for (int r = 0; r < 16; ++r) { p0[r] = __builtin_amdgcn_exp2f(p0[r] - m_run) * invl; p1[r] = __builtin_amdgcn_exp2f(p1[r] - m_run) * invl; }
#pragma unroll
            for (int hf = 0; hf < 2; ++hf)
#pragma unroll
                for (int a4 = 0; a4 < 4; ++a4) {
                    const float x0 = hf ? p1[4 * a4] : p0[4 * a4], x1 = hf ? p1[4 * a4 + 1] : p0[4 * a4 + 1], x2 = hf ? p1[4 * a4 + 2] : p0[4 * a4 + 2], x3 = hf ? p1[4 * a4 + 3] : p0[4 * a4 + 3];
                    float mainv = (x0 + x1) + (x2 + 0.5f * x3), carry = 0.5f * x3;
                    mainv += __shfl_xor(mainv, 1); mainv += __shfl_xor(mainv, 2); carry += __shfl_xor(carry, 1); carry += __shfl_xor(carry, 2);
                    const int mb = 16 * tc + 8 * hf + 2 * a4 + hi;
                    if (j == 0) { (void)__hip_atomic_fetch_add(IMP + toff * IMP_LD + mb, mainv, __ATOMIC_RELAXED, __HIP_MEMORY_SCOPE_WORKGROUP);
                                  (void)__hip_atomic_fetch_add(IMP + toff * IMP_LD + mb + 1, carry, __ATOMIC_RELAXED, __HIP_MEMORY_SCOPE_WORKGROUP); }
                }
            pack_p(p0, p1, pa0, pa1, pa2, pa3);
            pv_all(o, vb0 + (tc & 1) * 16384, pa0, pa1, pa2, pa3);
            if (tc + 1 < ntc) NSA_SWRITE((tc + 1) & 1);
            __syncthreads();
        }
        { size_t gb = gbase; float* ab = ACCw; asm volatile("" : "+v"(gb), "+v"(ab));
          float gt[16];
#pragma unroll
          for (int r = 0; r < 16; ++r) gt[r] = MS[gb + (2 * (r >> 2)) * 40 + (r & 3) * 3 + 0];
#pragma unroll
          for (int r = 0; r < 16; ++r) { const float g_ = sigmoidf_(gt[r]);
#pragma unroll
              for (int d0 = 0; d0 < 4; ++d0) ab[(r * 4 + d0) * 64] = g_ * o[d0][r]; } }
    }
    if (dry == 2) { __syncthreads(); return; }
    {
        const int q = tid >> 3, mt = tid & 7;
        unsigned mk0 = 0u, mk1 = 0u, mk2 = 0u, mk3 = 0u;
        if (qb < 16) { mk0 = (2u << qb) - 1u; }
        else {
            unsigned key[16];
#pragma unroll
            for (int k = 0; k < 16; ++k) { const int m = mt + 8 * k; const bool cand = (m >= 1) && (m <= qb - 2); key[k] = cand ? (__float_as_uint(IMP[q * IMP_LD + m]) + 1u) : 0u; }
            unsigned ans = 0u;
            for (int bit = 30; bit >= 0; --bit) { const unsigned trial = ans | (1u << bit); int c = 0;
#pragma unroll
                for (int k = 0; k < 16; ++k) c += (key[k] >= trial) ? 1 : 0;
                c = sum8_dpp(c);
                if (c >= 13) ans = trial; }
            int cg = 0;
#pragma unroll
            for (int k = 0; k < 16; ++k) cg += (key[k] > ans) ? 1 : 0;
            cg = sum8_dpp(cg);
            const int rtake = 13 - cg; int run = 0;
#pragma unroll
            for (int k = 0; k < 16; ++k) { const bool tie = key[k] == ans && ans != 0u; const unsigned long long bal = __ballot(tie);
                const unsigned grp = (unsigned)(bal >> (8 * (lane >> 3))) & 0xffu; const int before = __popc(grp & ((1u << mt) - 1u));
                const bool take = (key[k] > ans) || (tie && (run + before) < rtake);
                run += __popc(grp);
                const unsigned bitv = take ? (1u << (8 * (k & 3) + mt)) : 0u;
                if ((k >> 2) == 0) mk0 |= bitv; else if ((k >> 2) == 1) mk1 |= bitv; else if ((k >> 2) == 2) mk2 |= bitv; else mk3 |= bitv; }
            mk0 |= 1u;
            { const int f1 = qb - 1, f2 = qb; const unsigned b1 = 1u << (f1 & 31), b2 = 1u << (f2 & 31);
              if ((f1 >> 5) == 0) mk0 |= b1; else if ((f1 >> 5) == 1) mk1 |= b1; else if ((f1 >> 5) == 2) mk2 |= b1; else mk3 |= b1;
              if ((f2 >> 5) == 0) mk0 |= b2; else if ((f2 >> 5) == 1) mk1 |= b2; else if ((f2 >> 5) == 2) mk2 |= b2; else mk3 |= b2; }
            mk0 |= __shfl_xor(mk0, 1); mk0 |= __shfl_xor(mk0, 2); mk0 |= __shfl_xor(mk0, 4);
            mk1 |= __shfl_xor(mk1, 1); mk1 |= __shfl_xor(mk1, 2); mk1 |= __shfl_xor(mk1, 4);
            mk2 |= __shfl_xor(mk2, 1); mk2 |= __shfl_xor(mk2, 2); mk2 |= __shfl_xor(mk2, 4);
            mk3 |= __shfl_xor(mk3, 1); mk3 |= __shfl_xor(mk3, 2); mk3 |= __shfl_xor(mk3, 4);
        }
        if (mt == 0) *(LAS u32x4*)(SELM + q * 4) = (u32x4){mk0, mk1, mk2, mk3};
    }
    __syncthreads();
    unsigned long long um_lo, um_hi; u32x4 mysel;
    { u32x4 x = *(const LAS u32x4*)(SELM + lane * 4);
#pragma unroll
      for (int o_ = 1; o_ < 64; o_ <<= 1) { x.x |= __shfl_xor(x.x, o_); x.y |= __shfl_xor(x.y, o_); x.z |= __shfl_xor(x.z, o_); x.w |= __shfl_xor(x.w, o_); }
      um_lo = ((unsigned long long)(unsigned)__builtin_amdgcn_readfirstlane((int)x.y) << 32) | (unsigned)__builtin_amdgcn_readfirstlane((int)x.x);
      um_hi = ((unsigned long long)(unsigned)__builtin_amdgcn_readfirstlane((int)x.w) << 32) | (unsigned)__builtin_amdgcn_readfirstlane((int)x.z);
      mysel = *(const LAS u32x4*)(SELM + toff * 4); }
    const unsigned long long my_lo = ((unsigned long long)mysel.y << 32) | mysel.x, my_hi = ((unsigned long long)mysel.w << 32) | mysel.z;

    if (dry == 3) { asm volatile("" :: "v"(my_lo), "v"(my_hi)); __syncthreads(); return; }
    {
        const bf16* KSp = (const bf16*)(ws + WS_KS) + (size_t)bg * S * 128; const bf16* VSp = (const bf16*)(ws + WS_VS) + (size_t)bg * S * 128;
        m_run = -1e30f; l_run = 0.f;
#pragma unroll
        for (int d = 0; d < 4; ++d) o[d] = f32x16{};
        int m = next_bit(um_lo, um_hi, 0), it = 0;
        NSA_SLOAD(KSp + (size_t)m * 64 * 128, VSp + (size_t)m * 64 * 128); NSA_SWRITE(0); __syncthreads();
        while (m >= 0) {
            const int mn2 = next_bit(um_lo, um_hi, m + 1);
            if (mn2 >= 0) NSA_SLOAD(KSp + (size_t)mn2 * 64 * 128, VSp + (size_t)mn2 * 64 * 128);
            const bool selb = (m < 64) ? ((my_lo >> m) & 1ull) != 0ull : ((my_hi >> (m - 64)) & 1ull) != 0ull;
            if (__any(selb)) {
                qkt(p0, p1, lds + L_K + (it & 1) * 16384, qr, r32, hi);
                NSA_MASK(p0, p1, -1, selb ? (tq - 64 * m - 4 * hi) : -1, slope2, slope2 * (float)(64 * m + 4 * hi - tq));
                NSA_ONLINE(p0, p1);
                pack_p(p0, p1, pa0, pa1, pa2, pa3);
                pv_all(o, vb0 + (it & 1) * 16384, pa0, pa1, pa2, pa3);
            }
            if (mn2 >= 0) NSA_SWRITE((it + 1) & 1);
            __syncthreads();
            m = mn2; ++it;
        }
        if (hi == 0) wsf[32 + r32] = l_run; asm volatile("s_waitcnt lgkmcnt(0)" ::: "memory");
        { size_t gb = gbase; float* ab = ACCw; asm volatile("" : "+v"(gb), "+v"(ab));
          float gt[16];
#pragma unroll
          for (int r = 0; r < 16; ++r) gt[r] = MS[gb + (2 * (r >> 2)) * 40 + (r & 3) * 3 + 1];
#pragma unroll
          for (int r = 0; r < 16; ++r) { const float sc_ = sigmoidf_(gt[r]) * __builtin_amdgcn_rcpf(wsf[32 + crow(r, hi)]);
#pragma unroll
              for (int d0 = 0; d0 < 4; ++d0) ab[(r * 4 + d0) * 64] += sc_ * o[d0][r]; } }
    }
    if (dry == 4) { __syncthreads(); return; }
    {
        const bf16* KWp = (const bf16*)(ws + WS_KW) + (size_t)bg * S * 128; const bf16* VWp = (const bf16*)(ws + WS_VW) + (size_t)bg * S * 128;
        m_run = -1e30f; l_run = 0.f;
#pragma unroll
        for (int d = 0; d < 4; ++d) o[d] = f32x16{};
        const int m0 = qb >= 8 ? qb - 8 : 0;
        __syncthreads();
        NSA_SLOAD(KWp + (size_t)m0 * 64 * 128, VWp + (size_t)m0 * 64 * 128); NSA_SWRITE(0); __syncthreads();
        for (int m = m0, it = 0; m <= qb; ++m, ++it) {
            if (m < qb) NSA_SLOAD(KWp + (size_t)(m + 1) * 64 * 128, VWp + (size_t)(m + 1) * 64 * 128);
            qkt(p0, p1, lds + L_K + (it & 1) * 16384, qr, r32, hi);
            NSA_MASK(p0, p1, tq - 512 - 64 * m - 4 * hi, tq - 64 * m - 4 * hi, slope2, slope2 * (float)(64 * m + 4 * hi - tq));
            NSA_ONLINE(p0, p1);
            pack_p(p0, p1, pa0, pa1, pa2, pa3);
            pv_all(o, vb0 + (it & 1) * 16384, pa0, pa1, pa2, pa3);
            if (m < qb) NSA_SWRITE((it + 1) & 1);
            __syncthreads();
        }
        if (hi == 0) wsf[32 + r32] = l_run; asm volatile("s_waitcnt lgkmcnt(0)" ::: "memory");
        const bf16* NZ = (const bf16*)(ws + WS_NZ); bf16* ON = (bf16*)(ws + WS_QN);
        { size_t gb = gbase, ob = obase; const float* ab = ACCw; asm volatile("" : "+v"(gb), "+v"(ab), "+v"(ob));
          float gt[16];
#pragma unroll
          for (int r = 0; r < 16; ++r) gt[r] = MS[gb + (2 * (r >> 2)) * 40 + (r & 3) * 3 + 2];
#pragma unroll
          for (int r = 0; r < 16; ++r) { const float sc_ = sigmoidf_(gt[r]) * __builtin_amdgcn_rcpf(wsf[32 + crow(r, hi)]);
              const size_t orow = ob + (2 * (r >> 2)) * 1024 + (r & 3) * 128;
#pragma unroll
              for (int d0 = 0; d0 < 4; ++d0) { const float z = __uint_as_float((unsigned)NZ[orow + 32 * d0] << 16);
                  const unsigned ov_ = cvt_pk_bf16((ab[(r * 4 + d0) * 64] + sc_ * o[d0][r]) * z, 0.f);
                  if (!dry) ON[orow + 32 * d0] = (bf16)(ov_ & 0xffffu); else asm volatile("" :: "v"(ov_)); } } }
    }
    __syncthreads();
#undef NSA_SLOAD
#undef NSA_SWRITE
#undef NSA_MASK
#undef NSA_ONLINE
}

__device__ __forceinline__ void nsa_phase(unsigned char* ws, LAS unsigned char* lds, int c, int G, int tid, int lane, int w, int dry) {
    for (int cc = c; cc < 256; cc += G) { const int bgi = cc >> 6, s = cc & 63;
        nsa_unit(ws, lds, bgi >> 1, bgi & 1, 127 - s, tid, lane, w, dry);
        nsa_unit(ws, lds, bgi >> 1, bgi & 1, s, tid, lane, w, dry); }
}
#undef NSA_KSWZ
#undef NSA_SBAR
}

#ifndef REPC2
#define REPC2 1
#endif
#ifndef REP3BMODE
#define REP3BMODE 1
#endif
#ifndef REP4MODE
#define REP4MODE 1
#endif
#ifndef REP0
#define REP0 1
#endif
#ifndef REP1
#define REP1 1
#endif
#ifndef REP3
#define REP3 1
#endif
#ifndef REP3B
#define REP3B 1
#endif
#ifndef REP3PM
#define REP3PM 0
#endif
#ifndef REP3MODE
#define REP3MODE 1
#endif
#ifndef REP4
#define REP4 1
#endif
#ifndef REP5
#define REP5 1
#endif
constexpr int N_PHASES = 8;
__global__ void __launch_bounds__(NTHR, 2) fwd_kernel(Args args) {
    extern __shared__ __attribute__((aligned(16))) unsigned char lds_raw[];
    Frame F;
    F.lds = (LAS unsigned char*)lds_raw;
    F.wave = __builtin_amdgcn_readfirstlane((int)threadIdx.x >> 6);
    F.G = gridDim.x; { const int bx = blockIdx.x; F.vcu = (F.G % 8 == 0) ? (bx % 8) * (F.G / 8) + bx / 8 : bx; }
    unsigned char* ws = args.ws;
    gu32* ctl = (gu32*)(ws + WS_CTL);
    volatile LAS unsigned* MISC = (volatile LAS unsigned*)(F.lds + MISC_OFF);
    for (int u = (F.wave * 64 + lane_id()); u < (LDS_BYTES - LDSCTL_OFF) / 4; u += NTHR) ((LAS unsigned*)(F.lds + LDSCTL_OFF))[u] = 0u;
    __syncthreads();
    const int lo = args.ph_lo, hi = args.ph_hi;
    const bool multi = (hi - lo) > 1;
    XcdBarrier bar; bar.bar = (unsigned*)(ctl + CW_BAR); bar.x = 0; bar.st = nullptr; bar.wave = F.wave;
    if (multi) bar = xcd_barrier_post((unsigned*)(ctl + CW_BAR), MISC + 8, F.wave);
#define IN(k) (lo <= (k) && (k) < hi)
#define SEAM(k) do { if (IN(k) && IN((k) + 1)) xcd_barrier(bar); } while (0)
    bf16* MGN = (bf16*)args.out; bf16* MGD = MGN + (size_t)T * DM;
    const int bx = (int)blockIdx.x;

    if (IN(0)) { for (int rep = 0; rep < REP0; ++rep) p0_prologue(F, args); }
    SEAM(0);
    if (IN(1)) {
        { SchedPlain Sd; Sd.to.init(T / 256, NPAD / 256 - 1, WGM_INPROJ); Sd.G = F.G; Sd.c = bx;     Sd.A = (const char*)(ws + WS_XB); Sd.B = (const char*)(ws + WS_WIN); Sd.at = (size_t)256 * DM * 2; Sd.bt = (size_t)256 * DM * 2;
          EpiInProj E{ws, MGN, MGD, (LAS float*)(F.lds + LDSCTL_OFF + 2048)};
          for (int rep = 0; rep < REP1; ++rep) pg8::gemm_phase<DM, DM, DM>(F.lds + RING_OFF, F.wave, Sd, E); }
        { SchedTail St; St.G = F.G; St.c = bx; St.A = (const char*)(ws + WS_XB); St.B = (const char*)(ws + WS_WIN) + (size_t)44 * 256 * DM * 2; St.at = (size_t)256 * DM * 2;
          EpiMisc Em{ws};
          pg8::gemm_phase<DM, DM, DM, EpiMisc, SchedTail, true>(F.lds + RING_OFF, F.wave, St, Em); }
        { SchedPlain Sd; Sd.to.init(T / 256, DM / 256); const int nfull = (T / 256) % F.G;
          Sd.G = F.G - nfull; Sd.c = bx - nfull; if (Sd.G <= 0) { Sd.G = F.G; Sd.c = bx; }
          Sd.A = (const char*)(ws + WS_PB); Sd.B = (const char*)(ws + WS_WPP); Sd.at = (size_t)256 * 256 * 2; Sd.bt = (size_t)256 * 256 * 2;
          EpiBf16Plain E{(bf16*)(ws + WS_PP), DM};
          pg8::gemm_phase<256, 256, 256>(F.lds + RING_OFF, F.wave, Sd, E);
          const int ng = F.G - nfull;
          if (ng > 0 && ng < F.G) { if (bx >= nfull) tr_items(args, (LAS float*)(F.lds + RING_OFF + F.wave * 16384), TR_EARLY, TR_NITEMS, (bx - nfull) * NWAVES + F.wave, ng * NWAVES, lane_id()); }
          else tr_items(args, (LAS float*)(F.lds + RING_OFF + F.wave * 16384), TR_EARLY, TR_NITEMS, bx * NWAVES + F.wave, F.G * NWAVES, lane_id()); }
    }
    SEAM(1);
    if (IN(2)) {
        if (bx < 128) {
            SchedCmp Sd; Sd.c = bx; Sd.A0 = (const char*)(ws + WS_KCR); Sd.A1 = (const char*)(ws + WS_VCR); Sd.B0 = (const char*)(ws + WS_WC1K); Sd.B1 = (const char*)(ws + WS_WC1V);
            EpiCmp E{(float*)(ws + WS_CP4)};
            pg8::gemm_phase<512, 2048, 2048>(F.lds + RING_OFF, F.wave, Sd, E);
        }
        if (bx >= 128 || F.G <= 128) {
            const int nw = F.G > 128 ? (F.G - 128) * NWAVES : F.G * NWAVES, gw = (F.G > 128 ? bx - 128 : bx) * NWAVES + F.wave, ln = lane_id();
            const _Float16* IQh = (const _Float16*)(ws + WS_IQ); const float* MS = (const float*)(ws + WS_MISC); _Float16* QS = (_Float16*)(ws + WS_QS);
            for (int t = gw; t < T; t += nw) { float sum = 0.f;
#pragma unroll
                for (int h = 0; h < 16; ++h) { const _Float16 wq = (_Float16)(MS[(size_t)t * 40 + h] * 0.03125f); sum += (float)(IQh[(size_t)t * 1024 + h * 64 + ln] * wq); }
                sum *= 0.5f; const _Float16 hi = (_Float16)sum, lo = (_Float16)(sum - (float)hi);
                QS[(size_t)t * 128 + ln] = hi; QS[(size_t)t * 128 + 64 + ln] = lo; }
        }
        if (bx == F.G - 1) { const int idx = F.wave * 64 + lane_id(); const float* BPp = (const float*)(ws + WS_BIASP) + (idx >> 8) * 64 * 256 + (idx & 255); float sb = 0.f;
            for (int c = 0; c < 64; ++c) sb += BPp[c * 256];
            ((float*)(ws + WS_BIAS))[idx] = sb; }
    }
    SEAM(2);
    if (IN(3)) {
        LAS float* hbuf = (LAS float*)(F.lds + RING_OFF + F.wave * 4096);
        const int gw = F.vcu * NWAVES + F.wave, NGW = F.G * NWAVES;
        for (int rep = 0; rep < REPC2; ++rep) for (int task = gw; task < 1024; task += NGW) cmp2_task(args, task, hbuf, lane_id());
        __syncthreads();
        for (int rep = REP3 - 1; rep >= 0; --rep) { if (rep) dsa::dsa_phaseA<REP3PM>(ws, F.lds + RING_OFF, bx, F.G, lane_id(), F.wave, REP3MODE); else dsa::dsa_phaseA<0>(ws, F.lds + RING_OFF, bx, F.G, lane_id(), F.wave, 0); }
    }
    SEAM(3);
    if (IN(4)) {
        for (int rep = REP4 - 1; rep >= 0; --rep) nsa::nsa_phase(ws, F.lds + RING_OFF, F.vcu, F.G, (F.wave * 64 + lane_id()), lane_id(), F.wave, rep ? REP4MODE : 0);
        for (int rep = REP3B - 1; rep >= 0; --rep) dsa::dsa_phaseB(ws, F.lds + RING_OFF, F.vcu, F.G, lane_id(), F.wave, rep ? REP3BMODE : 0);
    }
    SEAM(4);
#ifdef EXTRA_BAR
    for (int eb = 0; eb < EXTRA_BAR; ++eb) xcd_barrier(bar);
#endif
    if (IN(5)) {
        SchedChain Sd; Sd.to.init(T / 256, DM / 256, WGM_OUT); Sd.G = F.G; Sd.c = bx;
        Sd.A0 = (const char*)(ws + WS_QN); Sd.B0 = (const char*)(ws + WS_WUPN); Sd.A1 = (const char*)(ws + WS_DQ); Sd.B1 = (const char*)(ws + WS_WUPD); Sd.at = (size_t)256 * 1024 * 2; Sd.bt = (size_t)256 * 1024 * 2;
        EpiY E{MGN, MGD, (bf16*)(ws + WS_XB)};
        for (int rep = 0; rep < REP5; ++rep) pg8::gemm_phase<1024, 1024, 1024>(F.lds + RING_OFF, F.wave, Sd, E);
    }
    SEAM(5);
    if (IN(6)) {
        SchedPlain Sd; Sd.to.init(T / 256, DM / 256, WGM_OUT); Sd.G = F.G; Sd.c = bx; Sd.A = (const char*)(ws + WS_XB); Sd.B = (const char*)(ws + WS_WOUT); Sd.at = (size_t)256 * DM * 2; Sd.bt = (size_t)256 * DM * 2;
        EpiX1 E{args.in[0], args.out, (bf16*)(ws + WS_X1B), (float*)(ws + WS_CTL + CTL_SS1)};
        pg8::gemm_phase<DM, DM, DM>(F.lds + RING_OFF, F.wave, Sd, E);
    }
    SEAM(6);
    if (IN(7)) {
        SchedPlain Sd; Sd.to.init(T / 256, DM / 256, WGM_OUT); Sd.G = F.G; Sd.c = bx; Sd.A = (const char*)(ws + WS_X1B); Sd.B = (const char*)(ws + WS_WG); Sd.at = (size_t)256 * DM * 2; Sd.bt = (size_t)256 * DM * 2;
        EpiFinal E{args.out, (const bf16*)(ws + WS_PP), (const float*)(ws + WS_CTL + CTL_SS1)};
        pg8::gemm_phase<DM, DM, DM>(F.lds + RING_OFF, F.wave, Sd, E);
    }
#undef IN
#undef SEAM
}

#ifndef MK_ONE_LAUNCH
#define MK_ONE_LAUNCH 1
#endif
extern "C" void kernel_launch(void* const* d_in, const int* in_sizes, int n_in, void* d_out, int out_size, void* d_ws, size_t ws_size, hipStream_t stream) {
    static int grid = 0;
    if (grid == 0) {
        if (n_in != 22 || in_sizes[0] != T * DM || out_size != T * DM || ws_size < WS_END) {
            fprintf(stderr, "kernel_launch: unexpected shapes: n_in %d in0 %d out %d ws %zu (need %zu)\n", n_in, n_in > 0 ? in_sizes[0] : -1, out_size, ws_size, (size_t)WS_END); grid = -1; return; }
        int dev = 0, cus = 0;
        if (hipGetDevice(&dev) != hipSuccess || hipDeviceGetAttribute(&cus, hipDeviceAttributeMultiprocessorCount, dev) != hipSuccess) { grid = -1; return; }
        if (hipFuncSetAttribute((const void*)fwd_kernel, hipFuncAttributeMaxDynamicSharedMemorySize, LDS_BYTES) != hipSuccess) { fprintf(stderr, "kernel_launch: hipFuncSetAttribute failed\n"); grid = -1; return; }
        int occ = 0;
        if (hipOccupancyMaxActiveBlocksPerMultiprocessor(&occ, (const void*)fwd_kernel, NTHR, LDS_BYTES) != hipSuccess || occ < 1) { fprintf(stderr, "kernel_launch: occupancy query: %d blocks per CU\n", occ); grid = -1; return; }
        (void)hipGetLastError();
        grid = cus;
    }
    if (grid < 0) return;
    if (hipMemsetAsync((char*)d_ws + WS_CTL, 0, CTL_ZERO_BYTES, stream) != hipSuccess) return;
    Args a{};
    for (int i = 0; i < 22; ++i) a.in[i] = (const float*)d_in[i];
    a.out = (float*)d_out; a.ws = (unsigned char*)d_ws;
    if (MK_ONE_LAUNCH) { a.ph_lo = 0; a.ph_hi = N_PHASES; hipLaunchKernelGGL(fwd_kernel, dim3(grid), dim3(NTHR), LDS_BYTES, stream, a); }
    else for (int p = 0; p < N_PHASES; ++p) { a.ph_lo = p; a.ph_hi = p + 1; hipLaunchKernelGGL(fwd_kernel, dim3(grid), dim3(NTHR), LDS_BYTES, stream, a); }
    const hipError_t le = hipPeekAtLastError();
    if (le != hipSuccess) fprintf(stderr, "kernel_launch: launch failed: %s\n", hipGetErrorName(le));
}
```

```cpp
#ifndef DSA_BATCH
#define DSA_BATCH 2
#endif
#ifndef WGM_INPROJ
#define WGM_INPROJ 7
#endif
#ifndef WGM_OUT
#define WGM_OUT 2
#endif
#include <hip/hip_runtime.h>
#include <cstdio>
#include <cstdint>

#define LAS __attribute__((address_space(3)))
#define GAS __attribute__((address_space(1)))
typedef unsigned short bf16;
typedef short bf16x8 __attribute__((ext_vector_type(8)));
typedef float f32x4 __attribute__((ext_vector_type(4)));
typedef float f32x2 __attribute__((ext_vector_type(2)));
typedef float f32x16 __attribute__((ext_vector_type(16)));
typedef unsigned u32x4 __attribute__((ext_vector_type(4)));
typedef unsigned u32x2 __attribute__((ext_vector_type(2)));
typedef GAS unsigned gu32;

constexpr int NB = 2, S = 8192, T = NB * S, DM = 2048, HD = 128;
constexpr int NIN = 11368, NPAD = 11520;
constexpr float EPS = 1e-6f;
constexpr float LOG2E = 1.4426950408889634f;
constexpr float QSCALE = 0.08838834764831845f * LOG2E;
constexpr int NWAVES = 8, NTHR = 512;

constexpr size_t MiB = 1u << 20;
constexpr size_t WS_CTL = 0, CTL_ZERO_BYTES = 1 * MiB;
constexpr size_t WS_R0 = 1 * MiB;
constexpr size_t WS_BIASP = 1 * MiB + 65536;
constexpr size_t WS_BIAS = 1 * MiB + 65536 + 131072;
constexpr size_t WS_GN = 1 * MiB + 65536 + 131072 + 4096;
constexpr size_t WS_MISC = 2 * MiB;
constexpr size_t WS_IK = 5 * MiB;
constexpr size_t WS_KC = 7 * MiB, WS_VC = 7 * MiB + 524288;
constexpr size_t WS_WIN = 8 * MiB;
constexpr size_t WS_WUPN = 53 * MiB, WS_WUPD = 57 * MiB, WS_WOUT = 61 * MiB, WS_WG = 69 * MiB, WS_WPP = 77 * MiB, WS_WC1K = 78 * MiB, WS_WC1V = 80 * MiB;
constexpr size_t WS_PB = 84 * MiB;
constexpr size_t WS_XB = 92 * MiB;
constexpr size_t WS_QN = 156 * MiB, WS_NZ = 188 * MiB, WS_DQ = 220 * MiB, WS_IQ = 252 * MiB, WS_DZ = 284 * MiB;
constexpr size_t WS_X1B = WS_IQ;
constexpr size_t WS_KCR = 316 * MiB, WS_VCR = 324 * MiB, WS_KS = 332 * MiB, WS_VS = 340 * MiB, WS_KW = 348 * MiB, WS_VW = 356 * MiB, WS_DK = 364 * MiB, WS_DV = 372 * MiB;
constexpr size_t WS_PP = 380 * MiB;
constexpr size_t WS_QS = 444 * MiB;
constexpr size_t WS_GIDX = 453 * MiB;
constexpr size_t WS_CP4 = 461 * MiB;
constexpr size_t WS_END = 493 * MiB;
constexpr int CW_TMO = 0;
constexpr int CW_BAR = 4096;
constexpr int CW_Q0 = 8192;
constexpr size_t CTL_BIAS = 327680;
constexpr size_t CTL_SS1 = 262144;

__device__ __forceinline__ unsigned cvt_pk_bf16(float lo, float hi) { unsigned r; asm volatile("v_cvt_pk_bf16_f32 %0, %1, %2" : "=v"(r) : "v"(lo), "v"(hi)); return r; }
typedef _Float16 f16x2_t __attribute__((ext_vector_type(2)));
typedef _Float16 f16x8 __attribute__((ext_vector_type(8)));
__device__ __forceinline__ unsigned cvt_pk_f16(float lo, float hi) { const f16x2_t h = {(_Float16)lo, (_Float16)hi}; return __builtin_bit_cast(unsigned, h); }
__device__ __forceinline__ float bf_lo(unsigned w) { return __uint_as_float(w << 16); }
__device__ __forceinline__ float bf_hi(unsigned w) { return __uint_as_float(w & 0xffff0000u); }
__device__ __forceinline__ float sigmoidf_(float v) { return __builtin_amdgcn_rcpf(1.0f + __builtin_amdgcn_exp2f(-LOG2E * v)); }
__device__ __forceinline__ int sum8_dpp(int v) {
    v += __builtin_amdgcn_update_dpp(0, v, 0xB1, 0xF, 0xF, false);
    v += __builtin_amdgcn_update_dpp(0, v, 0x4E, 0xF, 0xF, false);
    v += __builtin_amdgcn_update_dpp(0, v, 0x141, 0xF, 0xF, false);
    return v;
}
template <bool IS_MAX>
__device__ __forceinline__ float wave_minmax63(float v) {
    const int idn = IS_MAX ? (int)0xff800000u : (int)0x7f800000u;
#define WMM_STEP(ctrl, rmask) do { const float o_ = __int_as_float(__builtin_amdgcn_update_dpp(idn, __float_as_int(v), ctrl, rmask, 0xF, false)); v = IS_MAX ? (o_ > v ? o_ : v) : (o_ < v ? o_ : v); } while (0)
    WMM_STEP(0x111, 0xF); WMM_STEP(0x112, 0xF); WMM_STEP(0x114, 0xF); WMM_STEP(0x118, 0xF); WMM_STEP(0x142, 0xA); WMM_STEP(0x143, 0xC);
#undef WMM_STEP
    return v;
}
__device__ __forceinline__ float wave_sum(float v) {
#pragma unroll
    for (int o = 1; o < 64; o <<= 1) v += __shfl_xor(v, o);
    return v;
}
__device__ __forceinline__ int lane_id() { int l; asm volatile("v_mbcnt_lo_u32_b32 %0, -1, 0\n\tv_mbcnt_hi_u32_b32 %0, -1, %0" : "=v"(l)); return l; }
#define LDS_WAIT() asm volatile("s_waitcnt lgkmcnt(0)" ::: "memory")
#define VM_WAIT() asm volatile("s_waitcnt vmcnt(0)" ::: "memory")

namespace pg8 {
constexpr int BM = 256, BK = 64, HALF = 128, HTB = HALF * BK * 2, STAGE_BYTES = 8 * HTB, NXCD = 8, WGM = 4;
__host__ __device__ __forceinline__ int lds_byte(int r, int c) { return r * 128 + ((c * 2) ^ ((r & 7) << 4)); }
__host__ __device__ __forceinline__ void stage_rc(int b, int& R, int& C) { R = b >> 7; C = ((b & 127) ^ ((R & 7) << 4)) >> 1; }
__host__ __device__ __forceinline__ int perm32(int rho) { const int n = rho >> 4, i = rho & 15; return 8 * (i >> 2) + 4 * n + (i & 3); }

struct Unit { int pm, pn, tag; const char* A; const char* B; };

struct TileOrder {
    int nM, nN, nwg, wgm;
    __device__ __forceinline__ void init(int nM_, int nN_, int wgm_ = WGM) { nM = nM_; nN = nN_; nwg = nM * nN; wgm = wgm_; }
    __device__ __forceinline__ void tile(int L, int& pm, int& pn) const {
        int wgid = L; { const int q = nwg / NXCD, r = nwg % NXCD, xcd = wgid % NXCD, off = wgid / NXCD; wgid = (xcd < r ? xcd * (q + 1) : r * (q + 1) + (xcd - r) * q) + off; }
        const int nig = wgm * nN, gid = wgid / nig, fm = gid * wgm, gsz = (nM - fm) < wgm ? (nM - fm) : wgm;
        pm = fm + ((wgid % nig) % gsz); pn = (wgid % nig) / gsz;
    }
};

template <int K, int lda, int ldb, class Epi, class Sched, bool HALFN = false>
__device__ __forceinline__ void gemm_phase(LAS unsigned char* lds, const int wid, const Sched& S, const Epi& E) {
    const int lane = lane_id(), tid = wid * 64 + lane, wr = wid >> 2, wc = wid & 3, fr = lane & 15, fq = lane >> 4;
    const int nt = K / BK;
    unsigned voffA, voffB;
    { int R, C; stage_rc(tid * 16, R, C); const int Rb = (R & ~31) + perm32(R & 31);
      voffA = (unsigned)(R * lda + C) * 2u; voffB = (unsigned)(Rb * ldb + C) * 2u; }
    constexpr size_t pstepA = (size_t)64 * lda * 2, pstepB = (size_t)64 * ldb * 2;
    const size_t kstep = (size_t)(BK * 2);
    const size_t hstepA = (size_t)HALF * lda * 2, hstepB = (size_t)HALF * ldb * 2;
    const unsigned ldsw = (unsigned)wid * 1024u;
    const int aoff = lds_byte(wr * 64 + fr, fq * 8), boff = lds_byte(wc * 32 + fr, fq * 8), aoff1 = aoff ^ 64, boff1 = boff ^ 64;
#define PG8_SA(b, h) (((b) * 2 + (h)) * HTB)
#define PG8_SB(b, h) ((4 + (b) * 2 + (h)) * HTB)
#define PG8_STAGE(bufoff, gbase, voff) do { const char* g1_ = (const char*)(gbase); const char* g2_ = g1_ + pstep_##voff; asm volatile("" : "+s"(g1_), "+s"(g2_)); \
        __builtin_amdgcn_global_load_lds((const unsigned*)(g1_ + (voff)), (LAS unsigned*)(lds + (bufoff) + ldsw), 16, 0, 0); \
        __builtin_amdgcn_global_load_lds((const unsigned*)(g2_ + (voff)), (LAS unsigned*)(lds + (bufoff) + ldsw + 8192), 16, 0, 0); } while (0)
#define pstep_voffA pstepA
#define pstep_voffB pstepB
#define PG8_LDA(dst, b, h) do { _Pragma("unroll") for (int m = 0; m < 4; ++m) _Pragma("unroll") for (int k = 0; k < 2; ++k) dst[m][k] = *(const LAS bf16x8*)(lds + PG8_SA(b, h) + (k ? aoff1 : aoff) + m * 2048); } while (0)
#define PG8_LDB(dst, b, h) do { _Pragma("unroll") for (int n = 0; n < 2; ++n) _Pragma("unroll") for (int k = 0; k < 2; ++k) dst[n][k] = *(const LAS bf16x8*)(lds + PG8_SB(b, h) + (k ? boff1 : boff) + n * 2048); } while (0)
#define PG8_MMA(ai, bj, At, Bt) do { __builtin_amdgcn_s_setprio(1); _Pragma("unroll") for (int m = 0; m < 4; ++m) _Pragma("unroll") for (int n = 0; n < 2; ++n) _Pragma("unroll") for (int k = 0; k < 2; ++k) \
        acc[ai][bj][m][n] = __builtin_amdgcn_mfma_f32_16x16x32_bf16(Bt[n][k], At[m][k], acc[ai][bj][m][n], 0, 0, 0); __builtin_amdgcn_s_setprio(0); } while (0)
#define PG8_LDB1(dst, b, h) do { if constexpr (!HALFN) PG8_LDB(dst, b, h); } while (0)
#define PG8_MMA1(ai, At, Bt) do { if constexpr (!HALFN) PG8_MMA(ai, 1, At, Bt); } while (0)
#define PG8_WAIT_V(n) asm volatile("s_waitcnt vmcnt(" #n ")" ::: "memory")
#define PG8_WAIT_L(n) asm volatile("s_waitcnt lgkmcnt(" #n ")" ::: "memory")
#define PG8_BAR __builtin_amdgcn_s_barrier()
#define PG8_SCHED __builtin_amdgcn_sched_barrier(0)
    Unit cur, nxt; int ui = 0;
    if (!S.next(0, cur)) return;
    f32x4 acc[2][2][4][2];
#pragma unroll
    for (int a = 0; a < 2; ++a)
#pragma unroll
        for (int b = 0; b < 2; ++b)
#pragma unroll
            for (int m = 0; m < 4; ++m)
#pragma unroll
                for (int n = 0; n < 2; ++n) acc[a][b][m][n] = (f32x4){0.f, 0.f, 0.f, 0.f};
    bf16x8 At[4][2], B0[2][2], B1[2][2];
    const char* cA = cur.A; const char* cB = cur.B;
    PG8_STAGE(PG8_SB(0, 0), cB, voffB); PG8_STAGE(PG8_SB(0, 1), cB + hstepB, voffB); PG8_STAGE(PG8_SA(0, 0), cA, voffA); PG8_STAGE(PG8_SA(0, 1), cA + hstepA, voffA);
    if (wr == 1) PG8_BAR;
    PG8_WAIT_V(2); PG8_BAR;
    PG8_STAGE(PG8_SB(1, 0), cB + kstep, voffB); PG8_STAGE(PG8_SA(1, 0), cA + kstep, voffA); PG8_STAGE(PG8_SB(1, 1), cB + hstepB + kstep, voffB);
    PG8_WAIT_V(6); PG8_BAR;
    for (;;) {
        const bool has_next = S.next(ui + 1, nxt);
        const char* nA = has_next ? nxt.A : cA; const char* nB = has_next ? nxt.B : cB;
        for (int t = 0; t < nt; t += 2) {
            const bool last = (t == nt - 2);
            const char* a1 = cA + (size_t)(t + 1) * kstep;
            const char* a2 = last ? nA : cA + (size_t)(t + 2) * kstep; const char* b2 = last ? nB : cB + (size_t)(t + 2) * kstep;
            const char* a3 = a2 + kstep; const char* b3 = b2 + kstep;
            PG8_LDB(B0, 0, 0); PG8_LDB1(B1, 0, 1); PG8_SCHED; PG8_LDA(At, 0, 0); PG8_STAGE(PG8_SA(1, 1), a1 + hstepA, voffA);
            PG8_WAIT_V(8); PG8_WAIT_L(0); PG8_BAR; PG8_MMA(0, 0, At, B0); PG8_MMA1(0, At, B1); PG8_BAR; PG8_SCHED;
            PG8_LDA(At, 0, 1); PG8_STAGE(PG8_SB(0, 0), b2, voffB); PG8_STAGE(PG8_SB(0, 1), b2 + hstepB, voffB); PG8_STAGE(PG8_SA(0, 0), a2, voffA);
            PG8_WAIT_V(8); PG8_WAIT_L(0); PG8_BAR; PG8_MMA(1, 0, At, B0); PG8_MMA1(1, At, B1); PG8_BAR; PG8_SCHED;
            PG8_LDB(B0, 1, 0); PG8_LDB1(B1, 1, 1); PG8_SCHED; PG8_LDA(At, 1, 0); PG8_STAGE(PG8_SA(0, 1), a2 + hstepA, voffA);
            PG8_WAIT_V(8); PG8_WAIT_L(0); PG8_BAR; PG8_MMA(0, 0, At, B0); PG8_MMA1(0, At, B1); PG8_BAR; PG8_SCHED;
            PG8_LDA(At, 1, 1); PG8_STAGE(PG8_SB(1, 0), b3, voffB); PG8_STAGE(PG8_SB(1, 1), b3 + hstepB, voffB); PG8_STAGE(PG8_SA(1, 0), a3, voffA);
            PG8_WAIT_V(8); PG8_WAIT_L(0); PG8_BAR; PG8_MMA(1, 0, At, B0); PG8_MMA1(1, At, B1); PG8_BAR; PG8_SCHED;
        }
        if (wr == 0) PG8_BAR;
        int lane_e = lane_id(); asm volatile("" : "+v"(lane_e));
        int wid_e = wid; asm volatile("" : "+s"(wid_e));
        const bool keep = E(acc, cur, wid_e >> 2, wid_e & 3, lane_e & 15, lane_e >> 4);
        __builtin_amdgcn_s_waitcnt(0x0F70);
        if (!has_next) break;
        if (!keep) {
#pragma unroll
            for (int a = 0; a < 2; ++a)
#pragma unroll
                for (int b = 0; b < 2; ++b)
#pragma unroll
                    for (int m = 0; m < 4; ++m)
#pragma unroll
                        for (int n = 0; n < 2; ++n) acc[a][b][m][n] = (f32x4){0.f, 0.f, 0.f, 0.f};
        }
        cur = nxt; cA = nA; cB = nB; ++ui;
        if (wr == 1) PG8_BAR;
    }
    PG8_WAIT_V(0);
    PG8_BAR;
#undef PG8_SA
#undef PG8_SB
#undef PG8_STAGE
#undef pstep_voffA
#undef pstep_voffB
#undef PG8_LDA
#undef PG8_LDB
#undef PG8_LDB1
#undef PG8_MMA1
#undef PG8_MMA
#undef PG8_WAIT_V
#undef PG8_WAIT_L
#undef PG8_BAR
#undef PG8_SCHED
}
}

#define XB_TMO      128
#define XB_XCNT(j)  (256  + 64 * (j))
#define XB_XSUB(j)  (1280 + 64 * (j))
#define XB_XGEN(j)  (2304 + 64 * (j))
#define XB_TOP      3328
#define XB_TOPGEN   3392
#define XCD_BAR_WORDS 3456
#define XB_SPIN_CAP (1u << 22)
__device__ __forceinline__ unsigned xb_ld(unsigned* p)              { return __hip_atomic_load(p, __ATOMIC_RELAXED, __HIP_MEMORY_SCOPE_AGENT); }
__device__ __forceinline__ unsigned xb_add(unsigned* p, unsigned v) { return __hip_atomic_fetch_add(p, v, __ATOMIC_RELAXED, __HIP_MEMORY_SCOPE_AGENT); }
__device__ __forceinline__ unsigned xb_xcc_id() { return (unsigned)__builtin_amdgcn_s_getreg((3 << 11) | 20) & 0xFu; }
#define XB_SPIN(cond, bar) do { unsigned _sp = 0; while (cond) { __builtin_amdgcn_s_sleep(1); \
    if ((++_sp & 255u) == 0u) { if (xb_ld(&(bar)[XB_TMO])) break; if (_sp > XB_SPIN_CAP) { atomicAdd(&(bar)[XB_TMO], 1u); break; } } } } while (0)
struct XcdBarrier { unsigned* bar; unsigned x; volatile LAS unsigned* st; int wave; };
__device__ __forceinline__ XcdBarrier xcd_barrier_post(unsigned* bar, volatile LAS unsigned* st, int wave) {
    XcdBarrier b; b.bar = bar; b.x = xb_xcc_id(); b.st = st; b.wave = wave;
    if (wave == 0 && lane_id() == 0) (void)xb_add(&bar[XB_XCNT(b.x)], 1u);
    return b;
}
__device__ __forceinline__ void xcd_barrier_complete(unsigned* bar, unsigned x, unsigned& nloc, unsigned& nx) {
    const unsigned G = gridDim.x * gridDim.y * gridDim.z;
    unsigned sum, cnt, mine, sp = 0u;
    for (;;) {
        sum = 0u; cnt = 0u; mine = 0u;
#pragma unroll
        for (unsigned j = 0; j < 16; ++j) { const unsigned c = xb_ld(&bar[XB_XCNT(j)]); sum += c; cnt += (c > 0u) ? 1u : 0u; mine = (j == x) ? c : mine; }
        if (sum == G) break;
        __builtin_amdgcn_s_sleep(1);
        if ((++sp & 255u) == 0u) { if (xb_ld(&bar[XB_TMO])) break; if (sp > XB_SPIN_CAP) { atomicAdd(&bar[XB_TMO], 1u); break; } }
    }
    nloc = mine > 0u ? mine : 1u; nx = cnt > 0u ? cnt : 1u;
}
__device__ __forceinline__ void xcd_barrier(const XcdBarrier& b) {
    asm volatile("s_waitcnt vmcnt(0)" ::: "memory");
    __syncthreads();
    if (b.wave == 0 && lane_id() == 0) {
        unsigned* bar = b.bar;
        __builtin_amdgcn_s_waitcnt(0);
        unsigned nloc = b.st[0], nx = b.st[1];
        if (nloc == 0u) { xcd_barrier_complete(bar, b.x, nloc, nx); b.st[0] = nloc; b.st[1] = nx; }
        const unsigned old = xb_add(&bar[XB_XSUB(b.x)], 1u);
        const unsigned gen = old / nloc;
        if (old + 1u == (gen + 1u) * nloc) {
            __builtin_amdgcn_fence(__ATOMIC_RELEASE, "agent");
            asm volatile("s_waitcnt vmcnt(0)" ::: "memory");
            const unsigned og = xb_add(&bar[XB_TOP], 1u);
            const unsigned tg = og / nx;
            if (og + 1u == (tg + 1u) * nx) xb_add(&bar[XB_TOPGEN], 1u);
            else XB_SPIN(xb_ld(&bar[XB_TOPGEN]) == tg, bar);
            __builtin_amdgcn_fence(__ATOMIC_ACQUIRE, "agent");
            xb_add(&bar[XB_XGEN(b.x)], 1u);
            asm volatile("s_waitcnt vmcnt(0)" ::: "memory");
        } else {
            XB_SPIN(xb_ld(&bar[XB_XGEN(b.x)]) == gen, bar);
            __builtin_amdgcn_fence(__ATOMIC_ACQUIRE, "agent");
            asm volatile("s_waitcnt vmcnt(0)" ::: "memory");
        }
    }
    __syncthreads();
}

constexpr int RING_OFF = 0, RING_BYTES = 131072;
constexpr int LDSCTL_OFF = RING_BYTES, MISC_OFF = LDSCTL_OFF + 320;
constexpr int LDS_BYTES = 163840;

struct Args {
    const float* in[22];
    float* out; unsigned char* ws;
    int ph_lo, ph_hi;
};

struct Frame {
    LAS unsigned char* lds;
    int wave, vcu, G;
};

__device__ __forceinline__ void tr_item(const float* W, int ldw, const float* gain, int k0, int c0, int cn, bf16* WT, int ldt, int drow0, int dk0, LAS float* scr, int lane) {
    { const int rsub = lane >> 3, c4 = (lane & 7) * 4; f32x4 v[8];
#pragma unroll
      for (int i = 0; i < 8; ++i) v[i] = (c4 < cn) ? *(const f32x4*)(W + (size_t)(k0 + 8 * i + rsub) * ldw + c0 + c4) : (f32x4){0.f, 0.f, 0.f, 0.f};
#pragma unroll
      for (int i = 0; i < 8; ++i) { const int kk = 8 * i + rsub; const float g_ = gain ? gain[k0 + kk] : 1.0f; LAS float* d = scr + kk * 33 + c4;
          d[0] = v[i].x * g_; d[1] = v[i].y * g_; d[2] = v[i].z * g_; d[3] = v[i].w * g_; } }
    LDS_WAIT(); asm volatile("" ::: "memory");
    const int c = lane & 7;
#pragma unroll
    for (int j = 0; j < 4; ++j) { const int n = (lane >> 3) + 8 * j; const LAS float* s = scr + (8 * c) * 33 + n;
        u32x4 o; o.x = cvt_pk_bf16(s[0 * 33], s[1 * 33]); o.y = cvt_pk_bf16(s[2 * 33], s[3 * 33]); o.z = cvt_pk_bf16(s[4 * 33], s[5 * 33]); o.w = cvt_pk_bf16(s[6 * 33], s[7 * 33]);
        if (n < cn) *(u32x4*)(WT + (size_t)(drow0 + n) * ldt + dk0 + 8 * c) = o; }
    LDS_WAIT(); asm volatile("" ::: "memory");
}
__device__ const int WIN_SEG[13][3] = {
    {0, 1024, 0}, {1024, 1536, 1024}, {2560, 24, 11264 + 80}, {2584, 1024, 2560}, {3608, 1024, 3584}, {4632, 256, 4608}, {4888, 256, 4864},
    {5144, 1024, 5120}, {6168, 64, 11264}, {6232, 16, 11264 + 64}, {6248, 1024, 6144}, {7272, 2048, 7168}, {9320, 2048, 9216}};
__device__ const int WIN_CB[14] = {0, 32, 80, 81, 113, 145, 153, 161, 193, 195, 196, 228, 292, 356};

constexpr int TR_I_WIN = 356 * 32, TR_I_UP = 64 * 16, TR_I_SQ = 64 * 32, TR_I_PP = 64 * 4, TR_I_C1 = 8 * 32;
constexpr int TR_EARLY = TR_I_WIN + TR_I_PP, TR_NITEMS = TR_EARLY + 2 * TR_I_UP + 2 * TR_I_SQ + 4 * TR_I_C1;
__device__ __forceinline__ void tr_items(const Args& a, LAS float* scr, int lo, int hi, int gw, int NGW, int lane) {
    unsigned char* ws = a.ws;
    for (int it = lo + gw; it < hi; it += NGW) {
        int r = it;
        if (r < TR_I_WIN) { const int cb = r >> 5, kb = r & 31; int sg = 0;
#pragma unroll
            for (int s = 1; s < 13; ++s) if (cb >= WIN_CB[s]) sg = s;
            const int off = (cb - WIN_CB[sg]) * 32, len = WIN_SEG[sg][1]; const int cn = (len - off) < 32 ? (len - off) : 32;
            tr_item(a.in[3], NIN, a.in[2], kb * 64, WIN_SEG[sg][0] + off, cn, (bf16*)(ws + WS_WIN), DM, WIN_SEG[sg][2] + off, kb * 64, scr, lane); continue; }
        r -= TR_I_WIN;
        if (r < TR_I_PP) { tr_item(a.in[21], DM, nullptr, (r & 3) * 64, (r >> 2) * 32, 32, (bf16*)(ws + WS_WPP), 256, (r >> 2) * 32, (r & 3) * 64, scr, lane); continue; } r -= TR_I_PP;
        if (r < TR_I_UP) { tr_item(a.in[16], DM, nullptr, (r & 15) * 64, (r >> 4) * 32, 32, (bf16*)(ws + WS_WUPN), 1024, (r >> 4) * 32, (r & 15) * 64, scr, lane); continue; } r -= TR_I_UP;
        if (r < TR_I_UP) { tr_item(a.in[17], DM, nullptr, (r & 15) * 64, (r >> 4) * 32, 32, (bf16*)(ws + WS_WUPD), 1024, (r >> 4) * 32, (r & 15) * 64, scr, lane); continue; } r -= TR_I_UP;
        if (r < TR_I_SQ) { tr_item(a.in[18], DM, nullptr, (r & 31) * 64, (r >> 5) * 32, 32, (bf16*)(ws + WS_WOUT), DM, (r >> 5) * 32, (r & 31) * 64, scr, lane); continue; } r -= TR_I_SQ;
        if (r < TR_I_SQ) { tr_item(a.in[20], DM, a.in[19], (r & 31) * 64, (r >> 5) * 32, 32, (bf16*)(ws + WS_WG), DM, (r >> 5) * 32, (r & 31) * 64, scr, lane); continue; } r -= TR_I_SQ;
        { const int which = r / (2 * TR_I_C1); r -= which * 2 * TR_I_C1; const int hi_ = r / TR_I_C1; r -= hi_ * TR_I_C1;
          const float* W = which ? a.in[12] : a.in[9]; bf16* WT = (bf16*)(ws + (which ? WS_WC1V : WS_WC1K));
          tr_item(W, 256, nullptr, hi_ * 2048 + (r & 31) * 64, (r >> 5) * 32, 32, WT, 2048, hi_ * 256 + (r >> 5) * 32, (r & 31) * 64, scr, lane); }
    }
}

__device__ __forceinline__ void p0_prologue(const Frame& F, const Args& a) {
    unsigned char* ws = a.ws;
    LAS float* scr = (LAS float*)(F.lds + RING_OFF + F.wave * 16384);
    const int gw = F.vcu * NWAVES + F.wave, NGW = F.G * NWAVES, lane = lane_id();
    tr_items(a, scr, 0, TR_EARLY, gw, NGW, lane);
    { bf16* WT = (bf16*)(ws + WS_WIN) + (size_t)(11264 + 104) * DM; const size_t n16 = (size_t)152 * DM * 2 / 16;
      for (size_t i = (size_t)gw * 64 + lane; i < n16; i += (size_t)NGW * 64) ((u32x4*)WT)[i] = (u32x4){0u, 0u, 0u, 0u}; }
    if (gw < 10) { const int i = gw * 64 + lane, k = i >> 7; const float* gp = k == 0 ? a.in[4] : k == 1 ? a.in[6] : k == 2 ? a.in[7] : k == 3 ? a.in[14] : a.in[15];
      ((float*)(ws + WS_GN))[i] = gp[i & 127] * ((k == 0 || k == 3) ? QSCALE : 1.0f); }
    for (int m = gw; m < T; m += NGW) {
        const f32x4* xr = (const f32x4*)(a.in[0] + (size_t)m * DM) + lane;
        f32x4 v[8]; float s = 0.f;
#pragma unroll
        for (int j = 0; j < 8; ++j) { v[j] = xr[64 * j]; s += (v[j].x * v[j].x + v[j].y * v[j].y) + (v[j].z * v[j].z + v[j].w * v[j].w); }
        s = wave_sum(s);
        u32x2* o8 = (u32x2*)((bf16*)(ws + WS_XB) + (size_t)m * DM) + lane;
#pragma unroll
        for (int j = 0; j < 8; ++j) o8[64 * j] = (u32x2){cvt_pk_bf16(v[j].x, v[j].y), cvt_pk_bf16(v[j].z, v[j].w)};
        if (lane == 0) ((float*)(ws + WS_R0))[m] = 1.0f / sqrtf(s * (1.0f / DM) + EPS);
    }
    { const size_t n8 = (size_t)T * 256 / 8; const f32x4* src = (const f32x4*)a.in[1]; u32x4* dst = (u32x4*)(ws + WS_PB);
      for (size_t i = (size_t)gw * 64 + lane; i < n8; i += (size_t)NGW * 64) { const f32x4 x0 = src[2 * i], x1 = src[2 * i + 1];
          dst[i] = (u32x4){cvt_pk_bf16(x0.x, x0.y), cvt_pk_bf16(x0.z, x0.w), cvt_pk_bf16(x1.x, x1.y), cvt_pk_bf16(x1.z, x1.w)}; } }
    for (int it = gw; it < 2 * 64 * 4; it += NGW) { const int which = it >> 8, c = (it >> 2) & 63, jq = it & 3, j = jq * 64 + lane;
        const float* pe = which ? a.in[11] : a.in[8]; const float* W = which ? a.in[12] : a.in[9];
        float s = 0.f;
#pragma unroll 8
        for (int k = c * 64; k < c * 64 + 64; ++k) s += pe[k] * W[(size_t)k * 256 + j];
        ((float*)(ws + WS_BIASP))[(which * 64 + c) * 256 + j] = s; }
}

struct SchedPlain {
    pg8::TileOrder to; int G, c; const char* A; const char* B; size_t at, bt;
    __device__ __forceinline__ bool next(int i, pg8::Unit& u) const {
        if (c < 0) return false;
        const long L = (long)i * G + c; if (L >= to.nwg) return false;
        to.tile((int)L, u.pm, u.pn); u.tag = 0; u.A = A + (size_t)u.pm * at; u.B = B + (size_t)u.pn * bt; return true; }
};
struct SchedChain {
    pg8::TileOrder to; int G, c; const char* A0; const char* B0; const char* A1; const char* B1; size_t at, bt;
    __device__ __forceinline__ bool next(int i, pg8::Unit& u) const {
        const long L = (long)(i >> 1) * G + c; if (L >= to.nwg) return false;
        to.tile((int)L, u.pm, u.pn); u.tag = i & 1; u.A = ((i & 1) ? A1 : A0) + (size_t)u.pm * at; u.B = ((i & 1) ? B1 : B0) + (size_t)u.pn * bt; return true; }
};
struct SchedCmp {
    int c; const char* A0; const char* A1; const char* B0; const char* B1;
    __device__ __forceinline__ bool next(int i, pg8::Unit& u) const {
        if (i > 0 || c >= 128) return false;
        const int unit = c >> 2, split = c & 3, kv = unit >> 4, rem = unit & 15; u.pm = rem >> 1; u.pn = rem & 1; u.tag = kv * 4 + split;
        u.A = (kv ? A1 : A0) + (size_t)u.pm * (256u * 2048u * 2u) + (size_t)split * 1024u; u.B = (kv ? B1 : B0) + (size_t)u.pn * (256u * 2048u * 2u) + (size_t)split * 1024u; return true; }
};

__device__ __forceinline__ u32x4 pack8(const f32x4 v0, const f32x4 v1) { return (u32x4){cvt_pk_bf16(v0[0], v0[1]), cvt_pk_bf16(v0[2], v0[3]), cvt_pk_bf16(v1[0], v1[1]), cvt_pk_bf16(v1[2], v1[3])}; }
__device__ __forceinline__ u32x4 pack8h(const f32x4 v0, const f32x4 v1) { return (u32x4){cvt_pk_f16(v0[0], v0[1]), cvt_pk_f16(v0[2], v0[3]), cvt_pk_f16(v1[0], v1[1]), cvt_pk_f16(v1[2], v1[3])}; }
__device__ __forceinline__ void unpack8(const u32x4 w, f32x4& v0, f32x4& v1) { v0 = (f32x4){bf_lo(w.x), bf_hi(w.x), bf_lo(w.y), bf_hi(w.y)}; v1 = (f32x4){bf_lo(w.z), bf_hi(w.z), bf_lo(w.w), bf_hi(w.w)}; }

struct EpiInProj {
    unsigned char* ws; bf16* MGN; bf16* MGD; LAS float* P;
    __device__ __forceinline__ bool operator()(f32x4 (&acc)[2][2][4][2], const pg8::Unit& u, int wr, int wc, int fr, int fq) const {
        const int pn = u.pn, row0 = u.pm * 256 + wr * 64 + fr, colw = wc * 32 + 8 * fq;
        const float* R0 = (const float*)(ws + WS_R0);
        float rs[2][4];
#pragma unroll
        for (int ai = 0; ai < 2; ++ai)
#pragma unroll
            for (int m = 0; m < 4; ++m) rs[ai][m] = R0[row0 + ai * 128 + m * 16];
        if (pn < 4 || pn == 6 || pn == 8 || (pn >= 14 && pn <= 18)) {
#pragma unroll
            for (int ai = 0; ai < 2; ++ai)
#pragma unroll
                for (int m = 0; m < 4; ++m)
#pragma unroll
                    for (int bj = 0; bj < 2; ++bj) { const f32x4 v0 = acc[ai][bj][m][0] * rs[ai][m], v1 = acc[ai][bj][m][1] * rs[ai][m];
                        acc[ai][bj][m][0] = v0; acc[ai][bj][m][1] = v1;
                        float ss = v0[0] * v0[0] + v0[1] * v0[1] + v0[2] * v0[2] + v0[3] * v0[3] + v1[0] * v1[0] + v1[1] * v1[1] + v1[2] * v1[2] + v1[3] * v1[3];
                        ss += __shfl_xor(ss, 16); ss += __shfl_xor(ss, 32);
                        if (fq == 0) P[((ai * 128 + wr * 64 + m * 16 + fr) * 2 + bj) * 4 + wc] = ss; }
            asm volatile("s_waitcnt lgkmcnt(0)" ::: "memory"); __builtin_amdgcn_s_barrier(); asm volatile("" ::: "memory");
            const float* gp = (const float*)(ws + WS_GN) + (pn < 4 ? 0 : pn == 6 ? 128 : pn == 8 ? 256 : pn < 18 ? 384 : 512) + colw;
            const f32x4 g0 = *(const f32x4*)gp, g1 = *(const f32x4*)(gp + 4);
#pragma unroll
            for (int ai = 0; ai < 2; ++ai)
#pragma unroll
                for (int m = 0; m < 4; ++m) {
#pragma unroll
                    for (int bj = 0; bj < 2; ++bj) { const f32x4 pp = *(LAS f32x4*)&P[((ai * 128 + wr * 64 + m * 16 + fr) * 2 + bj) * 4];
                        const float rr = 1.0f / sqrtf((pp[0] + pp[1] + pp[2] + pp[3]) * (1.0f / 128.0f) + EPS);
                        acc[ai][bj][m][0] = acc[ai][bj][m][0] * rr * g0; acc[ai][bj][m][1] = acc[ai][bj][m][1] * rr * g1; }
                    rs[ai][m] = 1.0f; }
        }
        if (pn == 44) {
#pragma unroll
            for (int ai = 0; ai < 2; ++ai)
#pragma unroll
                for (int m = 0; m < 4; ++m) { const int row = row0 + ai * 128 + m * 16; const f32x4 v0 = acc[ai][0][m][0] * rs[ai][m], v1 = acc[ai][0][m][1] * rs[ai][m];
                    if (colw < 64) *(u32x4*)((bf16*)(ws + WS_IK) + (size_t)row * 64 + colw) = pack8h(v0, v1);
                    else if (colw < 104) { float* p = (float*)(ws + WS_MISC) + (size_t)row * 40 + (colw - 64); *(f32x4*)p = v0; *(f32x4*)(p + 4) = v1; } }
            return false;
        }
        bf16* p0; size_t d1 = 128; int ldc = 1024, act = 0;
        if (pn < 4) p0 = (bf16*)(ws + WS_QN) + pn * 256;
        else if (pn < 10) { const size_t offs = pn == 4 ? WS_KCR : pn == 5 ? WS_VCR : pn == 6 ? WS_KS : pn == 7 ? WS_VS : pn == 8 ? WS_KW : WS_VW;
            p0 = (bf16*)(ws + offs) + (size_t)(u.pm >> 5) * S * 128; ldc = 128; d1 = (size_t)S * 128; }
        else if (pn < 14) { p0 = (bf16*)(ws + WS_NZ) + (pn - 10) * 256; act = 1; }
        else if (pn < 18) p0 = (bf16*)(ws + WS_DQ) + (pn - 14) * 256;
        else if (pn < 20) { p0 = (bf16*)(ws + (pn == 18 ? WS_DK : WS_DV)); ldc = 256; }
        else if (pn < 24) { p0 = (bf16*)(ws + WS_IQ) + (pn - 20) * 256; act = 3; }
        else if (pn < 28) { p0 = (bf16*)(ws + WS_DZ) + (pn - 24) * 256; act = 1; }
        else if (pn < 36) { p0 = MGN + (pn - 28) * 256; ldc = 2048; act = 2; }
        else { p0 = MGD + (pn - 36) * 256; ldc = 2048; act = 2; }
#pragma unroll
        for (int ai = 0; ai < 2; ++ai)
#pragma unroll
            for (int m = 0; m < 4; ++m) { bf16* rowp = p0 + (size_t)(row0 + ai * 128 + m * 16) * ldc + colw;
#pragma unroll
                for (int bj = 0; bj < 2; ++bj) { f32x4 v0 = acc[ai][bj][m][0] * rs[ai][m], v1 = acc[ai][bj][m][1] * rs[ai][m];
                    if (act == 1 || act == 2) {
#pragma unroll
                        for (int j = 0; j < 4; ++j) { const float s0 = sigmoidf_(v0[j]), s1 = sigmoidf_(v1[j]); v0[j] = act == 1 ? v0[j] * s0 : s0; v1[j] = act == 1 ? v1[j] * s1 : s1; } }
                    *(u32x4*)(rowp + bj * d1) = act == 3 ? pack8h(v0, v1) : pack8(v0, v1); } }
        return false;
    }
};
struct SchedTail {
    int G, c; const char* A; const char* B; size_t at;
    __device__ __forceinline__ bool next(int i, pg8::Unit& u) const {
        if (c < 0) return false;
        const long L = (long)i * G + c; if (L >= T / 256) return false;
        u.pm = (int)L; u.pn = 44; u.tag = 0; u.A = A + (size_t)u.pm * at; u.B = B; return true; }
};
struct EpiMisc {
    unsigned char* ws;
    __device__ __forceinline__ bool operator()(f32x4 (&acc)[2][2][4][2], const pg8::Unit& u, int wr, int wc, int fr, int fq) const {
        const int row0 = u.pm * 256 + wr * 64 + fr, colw = wc * 32 + 8 * fq;
        const float* R0 = (const float*)(ws + WS_R0);
#pragma unroll
        for (int ai = 0; ai < 2; ++ai)
#pragma unroll
            for (int m = 0; m < 4; ++m) { const int row = row0 + ai * 128 + m * 16; const float rs = R0[row]; const f32x4 v0 = acc[ai][0][m][0] * rs, v1 = acc[ai][0][m][1] * rs;
                if (colw < 64) *(u32x4*)((bf16*)(ws + WS_IK) + (size_t)row * 64 + colw) = pack8h(v0, v1);
                else if (colw < 104) { float* p = (float*)(ws + WS_MISC) + (size_t)row * 40 + (colw - 64); *(f32x4*)p = v0; *(f32x4*)(p + 4) = v1; } }
        return false;
    }
};
struct EpiBf16Plain {
    bf16* O; int ldc;
    __device__ __forceinline__ bool operator()(f32x4 (&acc)[2][2][4][2], const pg8::Unit& u, int wr, int wc, int fr, int fq) const {
        const int row0 = u.pm * 256 + wr * 64 + fr, col0 = u.pn * 256 + wc * 32 + 8 * fq;
#pragma unroll
        for (int ai = 0; ai < 2; ++ai)
#pragma unroll
            for (int m = 0; m < 4; ++m) { bf16* rowp = O + (size_t)(row0 + ai * 128 + m * 16) * ldc + col0;
#pragma unroll
                for (int bj = 0; bj < 2; ++bj) *(u32x4*)(rowp + bj * 128) = pack8(acc[ai][bj][m][0], acc[ai][bj][m][1]); }
        return false;
    }
};
struct EpiCmp {
    float* CP;
    __device__ __forceinline__ bool operator()(f32x4 (&acc)[2][2][4][2], const pg8::Unit& u, int wr, int wc, int fr, int fq) const {
        const int row0 = u.pm * 256 + wr * 64 + fr, col0 = u.pn * 256 + wc * 32 + 8 * fq;
        float* base = CP + (size_t)((u.tag & 3) * 2 + (u.tag >> 2)) * 2048 * 512;
#pragma unroll
        for (int ai = 0; ai < 2; ++ai)
#pragma unroll
            for (int m = 0; m < 4; ++m) { float* rowp = base + (size_t)(row0 + ai * 128 + m * 16) * 512 + col0;
#pragma unroll
                for (int bj = 0; bj < 2; ++bj) { *(f32x4*)(rowp + bj * 128) = acc[ai][bj][m][0]; *(f32x4*)(rowp + bj * 128 + 4) = acc[ai][bj][m][1]; } }
        return false;
    }
};
struct EpiY {
    const bf16* MGN; const bf16* MGD; bf16* Y;
    __device__ __forceinline__ bool operator()(f32x4 (&acc)[2][2][4][2], const pg8::Unit& u, int wr, int wc, int fr, int fq) const {
        const int row0 = u.pm * 256 + wr * 64 + fr, col0 = u.pn * 256 + wc * 32 + 8 * fq;
#pragma unroll
        for (int ai = 0; ai < 2; ++ai)
#pragma unroll
            for (int m = 0; m < 4; ++m) { const size_t off = (size_t)(row0 + ai * 128 + m * 16) * DM + col0;
#pragma unroll
                for (int bj = 0; bj < 2; ++bj) { f32x4 b0, b1; unpack8(*(const u32x4*)(MGD + off + bj * 128), b0, b1);
                    if (u.tag == 0) { f32x4 a0, a1; unpack8(*(const u32x4*)(MGN + off + bj * 128), a0, a1);
#pragma unroll
                        for (int j = 0; j < 4; ++j) { acc[ai][bj][m][0][j] *= a0[j] * __builtin_amdgcn_rcpf(b0[j]); acc[ai][bj][m][1][j] *= a1[j] * __builtin_amdgcn_rcpf(b1[j]); } }
                    else { u32x4 yv = pack8(acc[ai][bj][m][0] * b0, acc[ai][bj][m][1] * b1);
#ifdef DBG_T
                        if (((row0 + ai * 128 + m * 16) & (S - 1)) < DBG_T) yv = (u32x4){0u, 0u, 0u, 0u};
#endif
                        *(u32x4*)(Y + off + bj * 128) = yv; } } }
        return u.tag == 0;
    }
};
struct EpiX1 {
    const float* X; float* OUT; bf16* X1B; float* SS1;
    __device__ __forceinline__ bool operator()(f32x4 (&acc)[2][2][4][2], const pg8::Unit& u, int wr, int wc, int fr, int fq) const {
        const int row0 = u.pm * 256 + wr * 64 + fr, col0 = u.pn * 256 + wc * 32 + 8 * fq;
#pragma unroll
        for (int ai = 0; ai < 2; ++ai)
#pragma unroll
            for (int m = 0; m < 4; ++m) { const int row = row0 + ai * 128 + m * 16; const size_t off = (size_t)row * DM + col0; float ss = 0.f;
#pragma unroll
                for (int bj = 0; bj < 2; ++bj) { const f32x4 x0 = *(const f32x4*)(X + off + bj * 128), x1 = *(const f32x4*)(X + off + bj * 128 + 4);
                    const f32x4 v0 = x0 + acc[ai][bj][m][0], v1 = x1 + acc[ai][bj][m][1];
                    *(f32x4*)(OUT + off + bj * 128) = v0; *(f32x4*)(OUT + off + bj * 128 + 4) = v1; *(u32x4*)(X1B + off + bj * 128) = pack8(v0, v1);
                    ss += (v0[0] * v0[0] + v0[1] * v0[1]) + (v0[2] * v0[2] + v0[3] * v0[3]) + (v1[0] * v1[0] + v1[1] * v1[1]) + (v1[2] * v1[2] + v1[3] * v1[3]); }
                ss += __shfl_xor(ss, 16); ss += __shfl_xor(ss, 32);
                if (fq == 0) atomicAdd(SS1 + row, ss); }
        return false;
    }
};
struct EpiFinal {
    float* OUT; const bf16* PP; const float* SS1;
    __device__ __forceinline__ bool operator()(f32x4 (&acc)[2][2][4][2], const pg8::Unit& u, int wr, int wc, int fr, int fq) const {
        const int row0 = u.pm * 256 + wr * 64 + fr, col0 = u.pn * 256 + wc * 32 + 8 * fq;
#pragma unroll
        for (int ai = 0; ai < 2; ++ai)
#pragma unroll
            for (int m = 0; m < 4; ++m) { const int row = row0 + ai * 128 + m * 16; const size_t off = (size_t)row * DM + col0;
                const float r1 = 1.0f / sqrtf(SS1[row] * (1.0f / DM) + EPS);
#pragma unroll
                for (int bj = 0; bj < 2; ++bj) { f32x4 p0, p1; unpack8(*(const u32x4*)(PP + off + bj * 128), p0, p1);
                    f32x4 v0 = *(const f32x4*)(OUT + off + bj * 128), v1 = *(const f32x4*)(OUT + off + bj * 128 + 4);
#pragma unroll
                    for (int j = 0; j < 4; ++j) { v0[j] += p0[j] * sigmoidf_(acc[ai][bj][m][0][j] * r1); v1[j] += p1[j] * sigmoidf_(acc[ai][bj][m][1][j] * r1); }
                    *(f32x4*)(OUT + off + bj * 128) = v0; *(f32x4*)(OUT + off + bj * 128 + 4) = v1; } }
        return false;
    }
};

__device__ __forceinline__ void norm_rows(bf16* base, size_t nrows, const float* gain, float cs, int gw, int NGW, int lane) {
    const int sub = lane >> 4, c = lane & 15;
    f32x4 g0 = *(const f32x4*)(gain + c * 8), g1 = *(const f32x4*)(gain + c * 8 + 4);
    g0 = g0 * cs; g1 = g1 * cs;
    for (size_t r = (size_t)gw * 4 + sub; r < nrows; r += (size_t)NGW * 4) {
        u32x4* p = (u32x4*)(base + r * 128) + c; const u32x4 w = *p; f32x4 v0, v1; unpack8(w, v0, v1);
        float ss = (v0[0] * v0[0] + v0[1] * v0[1]) + (v0[2] * v0[2] + v0[3] * v0[3]) + (v1[0] * v1[0] + v1[1] * v1[1]) + (v1[2] * v1[2] + v1[3] * v1[3]);
        ss += __shfl_xor(ss, 1); ss += __shfl_xor(ss, 2); ss += __shfl_xor(ss, 4); ss += __shfl_xor(ss, 8);
        const float rr = 1.0f / sqrtf(ss * (1.0f / 128.0f) + EPS);
        *p = pack8(v0 * rr * g0, v1 * rr * g1);
    }
}

__device__ __forceinline__ void cmp2_task(const Args& a, int task, LAS float* hbuf, int lane) {
    unsigned char* ws = a.ws;
    const int which = task >> 9, bg = (task >> 7) & 3, n0 = (task & 127) * 4;
    const float* CP = (const float*)(ws + WS_CP4) + (size_t)which * 2048 * 512; const float* BP = (const float*)(ws + WS_BIAS) + which * 256;
    float bias[4];
#pragma unroll
    for (int q = 0; q < 4; ++q) bias[q] = BP[q * 64 + lane];
#pragma unroll
    for (int r = 0; r < 4; ++r) { const int n = n0 + r, n1 = (n + 1) < 512 ? (n + 1) : 511;
#pragma unroll
        for (int q = 0; q < 4; ++q) { const int j = q * 64 + lane;
            float v = bias[q];
#pragma unroll
            for (int sp = 0; sp < 4; ++sp) v += CP[(size_t)sp * 2 * 2048 * 512 + (size_t)(bg * 512 + n) * 512 + j] + CP[(size_t)sp * 2 * 2048 * 512 + (size_t)(bg * 512 + n1) * 512 + 256 + j];
            hbuf[r * 256 + j] = v * sigmoidf_(v); } }
    LDS_WAIT(); asm volatile("" ::: "memory");
    const float* W2 = which ? a.in[13] : a.in[10];
    f32x2 o[4] = {{0.f, 0.f}, {0.f, 0.f}, {0.f, 0.f}, {0.f, 0.f}};
#pragma unroll 16
    for (int j = 0; j < 256; ++j) { const f32x2 w = *(const f32x2*)(W2 + j * 128 + 2 * lane);
#pragma unroll
        for (int r = 0; r < 4; ++r) { const float h = hbuf[r * 256 + j]; o[r].x += h * w.x; o[r].y += h * w.y; } }
    bf16* dst = (bf16*)(ws + (which ? WS_VC : WS_KC)) + (size_t)bg * 512 * 128;
    const f32x2 g = which ? (f32x2){1.f, 1.f} : *(const f32x2*)(a.in[5] + 2 * lane);
#pragma unroll
    for (int r = 0; r < 4; ++r) { float sc = 1.f;
        if (!which) { const float ss = wave_sum(o[r].x * o[r].x + o[r].y * o[r].y); sc = 1.0f / sqrtf(ss * (1.0f / 128.0f) + EPS); }
        ((unsigned*)(dst + (size_t)(n0 + r) * 128))[lane] = cvt_pk_bf16(o[r].x * sc * g.x, o[r].y * sc * g.y); }
    LDS_WAIT(); asm volatile("" ::: "memory");
}

namespace dsa {
typedef short s16x4 __attribute__((ext_vector_type(4)));
typedef unsigned short u16x4 __attribute__((ext_vector_type(4)));
constexpr int L_HIST = 147456, L_H1 = 16384, L_H2 = 49152, L_H3 = 81920, L_CNT = 83968, L_THR = 86016, L_MM = 131072 + 12288, L_CCNT = 131072 + 12288 + 256, L_CAND = 86784, L_SEG = 90880, L_WCNT = 107264, L_IDX = 107520, L_PF = 109568, CAP = 256;
constexpr int VROW = 288, VST_W = 32 * VROW, KROW = 272, LB_WAVE = 512 + VST_W + 16 * KROW;
static_assert(L_IDX + 2048 <= 131072 && 8 * LB_WAVE <= 131072 && L_CAND + 4 * CAP * 4 <= L_SEG && L_SEG + 4 * 8 * 256 * 2 <= L_WCNT, "dsa LDS map");

__device__ __forceinline__ unsigned f2key(float f) { const unsigned u = __float_as_uint(f); return (u & 0x80000000u) ? ~u : (u | 0x80000000u); }
__device__ __forceinline__ float key2f(unsigned k) { return __uint_as_float((k & 0x80000000u) ? (k & 0x7fffffffu) : ~k); }
constexpr unsigned KY_INV = 0x7fc00000u;
__device__ __forceinline__ unsigned kykey(unsigned fb) { return fb == KY_INV ? 0u : f2key(__uint_as_float(fb)); }
__device__ __forceinline__ void lds_add(LAS unsigned* p, unsigned v) { (void)__hip_atomic_fetch_add(p, v, __ATOMIC_RELAXED, __HIP_MEMORY_SCOPE_WORKGROUP); }

template <int WPL>
__device__ __forceinline__ void scan_hist(const LAS unsigned* H, unsigned need, int lane, unsigned& T, unsigned& cab, unsigned& cat) {
    unsigned wv[WPL];
    if constexpr (WPL >= 4) {
#pragma unroll
        for (int j = 0; j < WPL / 4; ++j) { const u32x4 x = *(const LAS u32x4*)(H + WPL * lane + 4 * j); wv[4 * j] = x.x; wv[4 * j + 1] = x.y; wv[4 * j + 2] = x.z; wv[4 * j + 3] = x.w; }
    } else {
        const u32x2 x = *(const LAS u32x2*)(H + 2 * lane); wv[0] = x.x; wv[1] = x.y;
    }
    unsigned tot = 0;
#pragma unroll
    for (int j = 0; j < WPL; ++j) tot += (wv[j] & 0xffffu) + (wv[j] >> 16);
    unsigned incl = tot;
#pragma unroll
    for (int o = 1; o < 64; o <<= 1) { const unsigned v = __shfl_down(incl, o); if (lane + o < 64) incl += v; }
    const unsigned above = incl - tot;
    const bool mine = (above < need) && (need <= incl);
    unsigned running = above, Tl = 0, cb = 0, ct = 0; bool found = false;
#pragma unroll
    for (int j = 2 * WPL - 1; j >= 0; --j) { const unsigned c = (wv[j >> 1] >> (16 * (j & 1))) & 0xffffu;
        const bool hit = !found && (running + c >= need);
        if (hit) { Tl = (unsigned)j; cb = running; ct = c; found = true; }
        running += c; }
    const unsigned long long bm = __ballot(mine);
    const int L = bm ? (__ffsll((long long)bm) - 1) : 0;
    T = (unsigned)__builtin_amdgcn_readlane((int)(2 * WPL * lane + Tl), L);
    cab = (unsigned)__builtin_amdgcn_readlane((int)cb, L);
    cat = (unsigned)__builtin_amdgcn_readlane((int)ct, L);
}

__device__ __forceinline__ void scan_hist32(const LAS unsigned* H, unsigned need, int lane, unsigned& T, unsigned& cab, unsigned& cat) {
    unsigned wv[16];
#pragma unroll
    for (int j = 0; j < 4; ++j) { const u32x4 x = *(const LAS u32x4*)(H + 16 * lane + 4 * j); wv[4 * j] = x.x; wv[4 * j + 1] = x.y; wv[4 * j + 2] = x.z; wv[4 * j + 3] = x.w; }
    unsigned tot = 0;
#pragma unroll
    for (int j = 0; j < 16; ++j) tot += wv[j];
    unsigned incl = tot;
#pragma unroll
    for (int o = 1; o < 64; o <<= 1) { const unsigned v = __shfl_down(incl, o); if (lane + o < 64) incl += v; }
    const unsigned above = incl - tot;
    const bool mine = (above < need) && (need <= incl);
    unsigned running = above, Tl = 0, cb = 0, ct = 0; bool found = false;
#pragma unroll
    for (int j = 15; j >= 0; --j) { const unsigned c = wv[j];
        const bool hit = !found && (running + c >= need);
        if (hit) { Tl = (unsigned)j; cb = running; ct = c; found = true; }
        running += c; }
    const unsigned long long bm = __ballot(mine);
    const int L = bm ? (__ffsll((long long)bm) - 1) : 0;
    T = (unsigned)__builtin_amdgcn_readlane((int)(16 * lane + Tl), L);
    cab = (unsigned)__builtin_amdgcn_readlane((int)cb, L);
    cat = (unsigned)__builtin_amdgcn_readlane((int)ct, L);
}

__device__ __forceinline__ float med3_0(float x, float c) { return __builtin_amdgcn_fmed3f(x, 0.f, c); }
#define DSA_BAR do { asm volatile("s_waitcnt lgkmcnt(0)" ::: "memory"); __builtin_amdgcn_s_barrier(); asm volatile("" ::: "memory"); } while (0)
template <int PM>
__device__ __forceinline__ void dsa_select_tile(unsigned char* ws, LAS unsigned char* lds, const int b, const int t0, const int lane_in, const int w_in, const int dry, const int nrow) {
    int w = w_in; asm volatile("" : "+s"(w));
    int lane = lane_in; asm volatile("" : "+v"(lane));
    const int tid = w * 64 + lane;
    const int i16 = lane & 15, kg = lane >> 4;
    LAS unsigned* HIST = (LAS unsigned*)(lds + L_HIST);
    LAS unsigned* H1 = (LAS unsigned*)(lds + L_H1); LAS unsigned* H2 = (LAS unsigned*)(lds + L_H2); LAS unsigned* H3 = (LAS unsigned*)(lds + L_H3);
    LAS unsigned* CNT = (LAS unsigned*)(lds + L_CNT); LAS unsigned* THR = (LAS unsigned*)(lds + L_THR); LAS unsigned* MM = (LAS unsigned*)(lds + L_MM);
    LAS unsigned* CCNT = (LAS unsigned*)(lds + L_CCNT); LAS unsigned* CAND = (LAS unsigned*)(lds + L_CAND);
    LAS unsigned short* SEG = (LAS unsigned short*)(lds + L_SEG); LAS unsigned* WCNT = (LAS unsigned*)(lds + L_WCNT);
    LAS unsigned short* IDX = (LAS unsigned short*)(lds + L_IDX);
    const size_t row0 = (size_t)b * S + t0;
    unsigned ky[4][16];
    {
        const bf16* IQ = (const bf16*)(ws + WS_IQ); const bf16* IKb = (const bf16*)(ws + WS_IK) + (size_t)b * S * 64 + (size_t)i16 * 64 + 16 * kg; const float* MS = (const float*)(ws + WS_MISC);
        f16x8 afr[4][2], alin[2]; float cl[4][4];
#pragma unroll
        for (int q = 0; q < 4; ++q) {
            const _Float16 wq = (_Float16)(MS[(row0 + q) * 40 + i16] * 0.03125f);
#pragma unroll
            for (int s = 0; s < 2; ++s) { const f16x8 x = *(const f16x8*)(IQ + (row0 + q) * 1024 + i16 * 64 + 16 * kg + 8 * s); afr[q][s] = x * wq; }
            const f32x4 tw = *(const f32x4*)(MS + (row0 + q) * 40 + 4 * kg);
#pragma unroll
            for (int r = 0; r < 4; ++r) cl[q][r] = tw[r] >= 0.f ? 0.5f : -0.5f; }
#pragma unroll
        for (int s = 0; s < 2; ++s) { const f16x8 x = *(const f16x8*)((const bf16*)(ws + WS_QS) + (row0 + (i16 & 3)) * 128 + ((i16 >> 2) & 1) * 64 + 16 * kg + 8 * s);
            alin[s] = i16 < 8 ? x : (f16x8){0, 0, 0, 0, 0, 0, 0, 0}; }
        const int na = ((t0 + 3) >> 6) + 1;
        f16x8 kbuf[4][2];
        const char* IKc = (const char*)(ws + WS_IK) + (size_t)b * S * 128 + (size_t)((lane >> 3) * 128 + (((lane & 7) ^ (lane >> 3)) * 16));
        const unsigned slot0 = (unsigned)(size_t)(lds + w * 16384);
        LAS const unsigned char* rdp0 = lds + w * 16384 + i16 * 128 + (((2 * kg) ^ (i16 & 7)) * 16);
        LAS const unsigned char* rdp1 = lds + w * 16384 + i16 * 128 + (((2 * kg + 1) ^ (i16 & 7)) * 16);
#define DSA_DMA(a_, sl_) do { const char* g_ = IKc + (size_t)(a_) * 8192; const unsigned l_ = slot0 + (unsigned)(sl_) * 8192u; \
            _Pragma("unroll") for (int j_ = 0; j_ < 8; ++j_) { unsigned keep_; \
                asm volatile("s_mov_b32 %0, m0\n\ts_mov_b32 m0, %2\n\ts_nop 0\n\tglobal_load_lds_dwordx4 %1, off\n\ts_mov_b32 m0, %0" \
                             : "=&s"(keep_) : "v"(g_ + j_ * 1024), "s"(l_ + (unsigned)j_ * 1024u) : "memory"); } } while (0)
#define DSA_RDK(sl_) do { _Pragma("unroll") for (int tl_ = 0; tl_ < 4; ++tl_) { \
            kbuf[tl_][0] = *(LAS const f16x8*)(rdp0 + (sl_) * 8192 + tl_ * 2048); kbuf[tl_][1] = *(LAS const f16x8*)(rdp1 + (sl_) * 8192 + tl_ * 2048); } } while (0)
        if (w < na) DSA_DMA(w, 0);
        if (w + 8 < na) DSA_DMA(w + 8, 1);
#pragma unroll
        for (int ap = 0; ap < 16; ++ap) {
            const int a = ap * 8 + w;
            if (PM == 10) { asm volatile("" :: "v"(afr[0][0]), "v"(afr[1][1]), "v"(afr[2][0]), "v"(afr[3][1]), "v"(cl[0][0]), "v"(cl[3][3]), "v"(kbuf[ap & 3][ap & 1]));
#pragma unroll
                for (int q = 0; q < 4; ++q) ky[q][ap] = KY_INV; }
            else if (a < na) {
                if (a + 8 < na) asm volatile("s_waitcnt vmcnt(8)" ::: "memory"); else asm volatile("s_waitcnt vmcnt(0)" ::: "memory");
                DSA_RDK(ap & 1);
                asm volatile("s_waitcnt lgkmcnt(0)" ::: "memory");
                if (a + 16 < na) DSA_DMA(a + 16, ap & 1);
                __builtin_amdgcn_sched_barrier(0);
                f32x4 lin[4];
#pragma unroll
                for (int qq = 0; qq < 4; qq += 2) {
                    f32x4 accs[2][4];
                    if (qq == 0) {
#pragma unroll
                        for (int tl = 0; tl < 4; ++tl) {
                            f32x4 acc = __builtin_amdgcn_mfma_f32_16x16x32_f16(alin[0], kbuf[tl][0], (f32x4){0.f, 0.f, 0.f, 0.f}, 0, 0, 0);
                            lin[tl] = __builtin_amdgcn_mfma_f32_16x16x32_f16(alin[1], kbuf[tl][1], acc, 0, 0, 0); } }
                    if constexpr (PM == 8 || PM == 9) {
#pragma unroll
                        for (int q2 = 0; q2 < 2; ++q2)
#pragma unroll
                            for (int tl = 0; tl < 4; ++tl) { const f32x4 kf = __builtin_bit_cast(f32x4, kbuf[tl][q2]); accs[q2][tl] = kf; }
                    } else {
#pragma unroll
                    for (int q2 = 0; q2 < 2; ++q2)
#pragma unroll
                        for (int tl = 0; tl < 4; ++tl) {
                            f32x4 acc = __builtin_amdgcn_mfma_f32_16x16x32_f16(afr[qq + q2][0], kbuf[tl][0], (f32x4){0.f, 0.f, 0.f, 0.f}, 0, 0, 0);
                            accs[q2][tl] = __builtin_amdgcn_mfma_f32_16x16x32_f16(afr[qq + q2][1], kbuf[tl][1], acc, 0, 0, 0); }
                    }
                    __builtin_amdgcn_sched_barrier(0);
                    if constexpr (PM == 7 || PM == 9) {
#pragma unroll
                        for (int q2 = 0; q2 < 2; ++q2) {
#pragma unroll
                            for (int tl = 0; tl < 4; ++tl) asm volatile("" :: "v"(accs[q2][tl]));
                            ky[qq + q2][ap] = KY_INV; }
                    } else {
#pragma unroll
                    for (int q2 = 0; q2 < 2; ++q2) { const int q = qq + q2;
                        float part[4];
#pragma unroll
                        for (int tl = 0; tl < 4; ++tl) { const f32x4 acc = accs[q2][tl];
                            part[tl] = __builtin_fmaf(__builtin_fabsf(acc[3]), cl[q][3], __builtin_fmaf(__builtin_fabsf(acc[2]), cl[q][2],
                                       __builtin_fmaf(__builtin_fabsf(acc[1]), cl[q][1], __builtin_fmaf(__builtin_fabsf(acc[0]), cl[q][0], lin[tl][q])))); }
                        const auto r01 = __builtin_amdgcn_permlane16_swap(__float_as_uint(part[0]), __float_as_uint(part[1]), false, false);
                        const auto r23 = __builtin_amdgcn_permlane16_swap(__float_as_uint(part[2]), __float_as_uint(part[3]), false, false);
                        const float t01 = __uint_as_float(r01[0]) + __uint_as_float(r01[1]), t23 = __uint_as_float(r23[0]) + __uint_as_float(r23[1]);
                        const auto rr_ = __builtin_amdgcn_permlane32_swap(__float_as_uint(t01), __float_as_uint(t23), false, false);
                        const float tot = __uint_as_float(rr_[0]) + __uint_as_float(rr_[1]);
                        const bool valid = (64 * a + lane) <= (t0 + q);
                        ky[q][ap] = valid ? __float_as_uint(tot) : KY_INV;
                    }
                    }
                    __builtin_amdgcn_sched_barrier(0);
                }
            } else {
#pragma unroll
                for (int q = 0; q < 4; ++q) ky[q][ap] = KY_INV;
            }
        }
#undef DSA_DMA
#undef DSA_RDK
    }
    *(LAS u32x4*)(lds + L_HIST + tid * 32) = (u32x4){0u, 0u, 0u, 0u}; *(LAS u32x4*)(lds + L_HIST + tid * 32 + 16) = (u32x4){0u, 0u, 0u, 0u};
    if (tid < 8) CCNT[tid] = 0u;
    if (dry == 2) {
#pragma unroll
        for (int q = 0; q < 4; ++q)
#pragma unroll
            for (int ap = 0; ap < 16; ++ap) asm volatile("" :: "v"(ky[q][ap]));
        DSA_BAR;
        return;
    }
#pragma unroll
    for (int q = 0; q < 4; ++q) { float mn = INFINITY, mx = -INFINITY;
#pragma unroll
        for (int ap = 0; ap < 16; ++ap) { const float v = __uint_as_float(ky[q][ap]); asm("v_max_f32 %0, %1, %2" : "=v"(mx) : "v"(mx), "v"(v)); asm("v_min_f32 %0, %1, %2" : "=v"(mn) : "v"(mn), "v"(v)); }
        asm volatile("s_nop 1" : "+v"(mn), "+v"(mx));
        mn = wave_minmax63<false>(mn); mx = wave_minmax63<true>(mx);
        if (lane == 63) { MM[(q * 8 + w) * 2] = __float_as_uint(mn); MM[(q * 8 + w) * 2 + 1] = __float_as_uint(mx); } }
    DSA_BAR;
    unsigned bn[4][8];
#pragma unroll
    for (int q = 0; q < 4; ++q) { float flo = INFINITY, fhi = -INFINITY;
#pragma unroll
        for (int j = 0; j < 8; ++j) { const float a_ = __uint_as_float(MM[(q * 8 + j) * 2]), b_ = __uint_as_float(MM[(q * 8 + j) * 2 + 1]); flo = a_ < flo ? a_ : flo; fhi = b_ > fhi ? b_ : fhi; }
        const float sc = (fhi > flo) ? 1023.0f / (fhi - flo) : 0.f;
#pragma unroll
        for (int ap = 0; ap < 16; ++ap) { const float v = __uint_as_float(ky[q][ap]); const bool ok = v == v; int bi = (int)((v - flo) * sc); bi = bi > 1023 ? 1023 : (bi < 0 ? 0 : bi);
            if (ok) lds_add(HIST + q * 1024 + bi, 1u);
            bi = ok ? bi : 0x7ff;
            if (ap & 1) bn[q][ap >> 1] |= (unsigned)bi << 16; else bn[q][ap >> 1] = (unsigned)bi; } }
    DSA_BAR;
    if (w < 4) { unsigned B, cab, cat; scan_hist32(HIST + w * 1024, 256u, lane, B, cab, cat); if (lane == 0) { THR[w * 8 + 0] = B; THR[w * 8 + 1] = cab; THR[w * 8 + 2] = cat; } }
    DSA_BAR;
    bool slow = false;
#pragma unroll
    for (int q = 0; q < 4; ++q) { const unsigned B = THR[q * 8 + 0]; slow = slow || (THR[q * 8 + 2] > (unsigned)CAP);
#pragma unroll
        for (int ap = 0; ap < 16; ++ap) { const unsigned bi = (ap & 1) ? (bn[q][ap >> 1] >> 16) : (bn[q][ap >> 1] & 0xffffu);
            if (bi == B) { const unsigned slot = __hip_atomic_fetch_add(CCNT + q, 1u, __ATOMIC_RELAXED, __HIP_MEMORY_SCOPE_WORKGROUP); if (slot < (unsigned)CAP) CAND[q * CAP + slot] = kykey(ky[q][ap]); } } }
    DSA_BAR;
    if (!slow) {
        if (w < 4) {
            const unsigned n = THR[w * 8 + 2], need = 256u - THR[w * 8 + 1];
            unsigned myk[4], cg[4], ce[4];
#pragma unroll
            for (int k = 0; k < 4; ++k) { const unsigned i = (unsigned)lane + 64u * k; myk[k] = i < n ? CAND[w * CAP + i] : 0u; cg[k] = 0u; ce[k] = 0u; }
            for (unsigned j = 0; j < n; ++j) { const unsigned cj = CAND[w * CAP + j];
#pragma unroll
                for (int k = 0; k < 4; ++k) { cg[k] += cj > myk[k] ? 1u : 0u; ce[k] += cj == myk[k] ? 1u : 0u; } }
            unsigned Ktv = 0u, rv = 0u, cev = 0u;
#pragma unroll
            for (int k = 0; k < 4; ++k) { const bool ok = ((unsigned)lane + 64u * k < n) && cg[k] < need && need <= cg[k] + ce[k];
                const unsigned long long bm = __ballot(ok);
                if (bm) { const int L = __ffsll((long long)bm) - 1; Ktv = (unsigned)__builtin_amdgcn_readlane((int)myk[k], L); rv = need - (unsigned)__builtin_amdgcn_readlane((int)cg[k], L); cev = (unsigned)__builtin_amdgcn_readlane((int)ce[k], L); } }
            if (lane == 0) { THR[w * 8 + 4] = Ktv; THR[w * 8 + 5] = rv; THR[w * 8 + 6] = 256u - rv; THR[w * 8 + 7] = (cev == rv) ? 0u : 1u; }
        }
    } else {
        for (int o = tid * 16; o < 65536; o += NTHR * 16) *(LAS u32x4*)(lds + L_H1 + o) = (u32x4){0u, 0u, 0u, 0u};
        if (tid < 128) *(LAS u32x4*)(lds + L_H3 + tid * 16) = (u32x4){0u, 0u, 0u, 0u};
        if (tid < 4) THR[tid * 8 + 7] = 1u;
        DSA_BAR;
#pragma unroll
        for (int q = 0; q < 4; ++q)
#pragma unroll
            for (int ap = 0; ap < 16; ++ap) { const unsigned k = kykey(ky[q][ap]); if (k) lds_add(H1 + q * 2048 + (k >> 21), 1u << (((k >> 20) & 1u) * 16)); }
        DSA_BAR;
        if (w < 4) { unsigned T1, c1; { unsigned ct_; scan_hist<32>(H1 + w * 2048, 256u, lane, T1, c1, ct_); } if (lane == 0) { THR[w * 8 + 0] = T1; THR[w * 8 + 1] = c1; } }
        DSA_BAR;
        unsigned T1v[4];
#pragma unroll
        for (int q = 0; q < 4; ++q) T1v[q] = THR[q * 8 + 0];
#pragma unroll
        for (int q = 0; q < 4; ++q)
#pragma unroll
            for (int ap = 0; ap < 16; ++ap) { const unsigned k = kykey(ky[q][ap]); if ((k >> 20) == T1v[q]) { const unsigned b2 = (k >> 8) & 0xfffu; lds_add(H2 + q * 2048 + (b2 >> 1), 1u << ((b2 & 1u) * 16)); } }
        DSA_BAR;
        if (w < 4) { unsigned T2, c2; const unsigned need2 = 256u - THR[w * 8 + 1]; { unsigned ct_; scan_hist<32>(H2 + w * 2048, need2, lane, T2, c2, ct_); } if (lane == 0) { THR[w * 8 + 2] = T2; THR[w * 8 + 3] = c2; } }
        DSA_BAR;
        unsigned P2v[4];
#pragma unroll
        for (int q = 0; q < 4; ++q) P2v[q] = (T1v[q] << 12) | THR[q * 8 + 2];
#pragma unroll
        for (int q = 0; q < 4; ++q)
#pragma unroll
            for (int ap = 0; ap < 16; ++ap) { const unsigned k = kykey(ky[q][ap]); if ((k >> 8) == P2v[q]) { const unsigned b3 = k & 0xffu; lds_add(H3 + q * 128 + (b3 >> 1), 1u << ((b3 & 1u) * 16)); } }
        DSA_BAR;
        if (w < 4) { unsigned T3, c3; const unsigned need3 = 256u - THR[w * 8 + 1] - THR[w * 8 + 3]; { unsigned ct_; scan_hist<2>(H3 + w * 128, need3, lane, T3, c3, ct_); }
            if (lane == 0) { const unsigned r = need3 - c3; THR[w * 8 + 4] = (((THR[w * 8 + 0] << 12) | THR[w * 8 + 2]) << 8) | T3; THR[w * 8 + 5] = r; THR[w * 8 + 6] = 256u - r; } }
        DSA_BAR;
    }
    DSA_BAR;
    const bool ties = (THR[7] | THR[15] | THR[23] | THR[31]) != 0u;
    if (!ties) {
#pragma unroll
        for (int q = 0; q < 4; ++q) { float Ktq = key2f(THR[q * 8 + 4]); asm volatile("" : "+v"(Ktq)); unsigned base = 0u; LAS unsigned short* sg = SEG + (q * 8 + w) * 256;
#pragma unroll
            for (int ap = 0; ap < 16; ++ap) { const bool sel = __uint_as_float(ky[q][ap]) >= Ktq; const unsigned long long m = __ballot(sel);
                if (sel) sg[base + (unsigned)__popcll(m & ((1ull << lane) - 1ull))] = (unsigned short)(64 * (ap * 8 + w) + lane);
                base += (unsigned)__popcll(m); }
            if (lane == 0) WCNT[q * 8 + w] = base; }
        DSA_BAR;
        if (!dry || dry == 3) { unsigned short* G = (unsigned short*)(ws + WS_GIDX) + row0 * 256;
#pragma unroll
            for (int h = 0; h < 2; ++h) { const int e = tid + h * NTHR, q = e >> 8, pos = e & 255; unsigned off = 0u; int wv = 0; unsigned src = 0u;
#pragma unroll
                for (int j = 0; j < 8; ++j) { const unsigned c = WCNT[q * 8 + j]; if ((unsigned)pos >= off && (unsigned)pos < off + c) { wv = j; src = (unsigned)pos - off; } off += c; }
                G[(size_t)q * 256 + pos] = SEG[(q * 8 + wv) * 256 + src]; } }
    } else {
        unsigned Kt[4], rr[4], ngt[4];
#pragma unroll
        for (int q = 0; q < 4; ++q) { Kt[q] = THR[q * 8 + 4]; rr[q] = THR[q * 8 + 5]; ngt[q] = THR[q * 8 + 6]; }
        { unsigned myv = 0u;
#pragma unroll
          for (int q = 0; q < 4; ++q)
#pragma unroll
              for (int ap = 0; ap < 16; ++ap) { const unsigned k = kykey(ky[q][ap]);
                  const unsigned cg = (unsigned)__popcll(__ballot(k > Kt[q])), ce = (unsigned)__popcll(__ballot(k == Kt[q]));
                  if (lane == q * 16 + ap) myv = cg | (ce << 16); __builtin_amdgcn_sched_barrier(0); }
          CNT[(lane >> 4) * 128 + (lane & 15) * 8 + w] = myv; }
        DSA_BAR;
#pragma unroll
        for (int q = 0; q < 4; ++q) {
            const u32x2 cv = *(const LAS u32x2*)(CNT + q * 128 + 2 * lane);
            const unsigned sum = cv.x + cv.y; unsigned incl = sum;
#pragma unroll
            for (int o = 1; o < 64; o <<= 1) { const unsigned v = __shfl_up(incl, o); if (lane >= o) incl += v; }
            const unsigned excl = incl - sum;
            const int pv_ = (int)((w & 1) ? excl + cv.x : excl);
            unsigned Ktq = Kt[q]; asm volatile("" : "+v"(Ktq));
#pragma unroll
            for (int ap = 0; ap < 16; ++ap) {
                const int a = ap * 8 + w;
                const unsigned P = (unsigned)__builtin_amdgcn_readlane(pv_, a >> 1);
                const unsigned k = kykey(ky[q][ap]);
                const bool isg = k > Ktq, ise = k == Ktq;
                const unsigned long long mg = __ballot(isg), me = __ballot(ise), lower = (1ull << lane) - 1ull;
                const unsigned posg = (P & 0xffffu) + (unsigned)__popcll(mg & lower), rank = (P >> 16) + (unsigned)__popcll(me & lower);
                if (isg) IDX[q * 256 + posg] = (unsigned short)(64 * a + lane);
                else if (ise && rank < rr[q]) IDX[q * 256 + ngt[q] + rank] = (unsigned short)(64 * a + lane);
                __builtin_amdgcn_sched_barrier(0);
            }
        }
    DSA_BAR;
        if (!dry || dry == 3) { if (tid < 128) { const int q = tid >> 5, part = tid & 31;
            *(u32x4*)((unsigned short*)(ws + WS_GIDX) + (row0 + q) * 256 + part * 8) = *(const LAS u32x4*)(IDX + q * 256 + part * 8); } }
    }
    DSA_BAR;
}

__device__ __forceinline__ void dsa_attn_item(unsigned char* ws, LAS unsigned char* ldw, const int b, const int g, const int t, const int lane_in, const int dry, u32x2& idxreg, const int nb, const int ng, const int nt) {
    int lane = lane_in; asm volatile("" : "+v"(lane));
    const int i16 = lane & 15, kg = lane >> 4;
    const int nsel = (t + 1) < 256 ? (t + 1) : 256;
    const size_t row = (size_t)b * S + t;
    LAS unsigned short* idx = (LAS unsigned short*)ldw; LAS unsigned char* vst = ldw + 512;
    if (t >= 256) *(LAS u32x2*)(idx + 4 * lane) = idxreg;
    else { const unsigned i0 = 4u * (unsigned)lane; *(LAS u32x2*)(idx + 4 * lane) = (u32x2){i0 | ((i0 + 1u) << 16), (i0 + 2u) | ((i0 + 3u) << 16)}; }
    if (nt >= 256) idxreg = *(const u32x2*)((const unsigned short*)(ws + WS_GIDX) + ((size_t)nb * S + nt) * 256 + 4 * lane);
    (void)ng;
    const int hh = 4 * g + (i16 & 3);
    const bf16* DQp = (const bf16*)(ws + WS_DQ) + row * 1024 + hh * 128 + 16 * kg;
    bf16x8 bq[4];
#pragma unroll
    for (int s = 0; s < 4; ++s) bq[s] = *(const bf16x8*)(DQp + 64 * (s >> 1) + 8 * (s & 1));
    const bf16* DKb = (const bf16*)(ws + WS_DK) + (size_t)b * S * 256 + g * 128 + 8 * i16;
    LAS unsigned char* kwr = ldw + 512 + VST_W + (4 * kg) * KROW + 16 * i16;
    const LAS unsigned char* krd = ldw + 512 + VST_W + i16 * KROW + 32 * kg;
    const bf16* DVb = (const bf16*)(ws + WS_DV) + (size_t)b * S * 256 + g * 128 + 8 * i16;
    const float slope2 = __builtin_amdgcn_exp2f(-(float)(hh + 1)) * LOG2E;
    const int qd = i16 >> 2, pp = i16 & 3;
    const LAS unsigned char* vrd = vst + (4 * kg + qd) * VROW + 8 * pp;
    bf16x8 kb[4][4]; u32x4 va[8], vb2[8];
#define DSA_LOADKT(slot_, T_) do { const u16x4 k4_ = *(const LAS u16x4*)(idx + 16 * (T_) + 4 * kg); \
        _Pragma("unroll") for (int i_ = 0; i_ < 4; ++i_) { const int kidx_ = (int)k4_[i_];     \
            kb[slot_][i_] = *(const bf16x8*)(DKb + (size_t)kidx_ * 256); } } while (0)
#define DSA_LOADVH(dst_, u_) do { int raw_[8]; _Pragma("unroll") for (int i_ = 0; i_ < 8; ++i_) raw_[i_] = (int)idx[32 * (u_) + 4 * i_ + kg];     \
        _Pragma("unroll") for (int i_ = 0; i_ < 8; ++i_) { const int li_ = 32 * (u_) + 4 * i_ + kg; const int kidx_ = (li_ < nsel) ? raw_[i_] : 0; \
        dst_[i_] = *(const u32x4*)(DVb + (size_t)kidx_ * 256); } } while (0)
    asm volatile("s_waitcnt lgkmcnt(0)" ::: "memory");
    if (dry != 5) {
#pragma unroll
    for (int Tt = 0; Tt < 4; ++Tt) DSA_LOADKT(Tt, Tt);
    }
    DSA_LOADVH(va, 0);
    f32x4 st[16];
#pragma unroll
    for (int Tt = 0; Tt < 16; ++Tt) { f32x4 acc = (f32x4){0.f, 0.f, 0.f, 0.f};
        if (dry != 5) {
#pragma unroll
        for (int i = 0; i < 4; ++i) *(LAS bf16x8*)(kwr + i * KROW) = kb[Tt & 3][i];
        bf16x8 kf[4];
#pragma unroll
        for (int s = 0; s < 4; ++s) kf[s] = *(const LAS bf16x8*)(krd + 128 * (s >> 1) + 16 * (s & 1));
#pragma unroll
        for (int s = 0; s < 4; ++s) acc = __builtin_amdgcn_mfma_f32_16x16x32_bf16(kf[s], bq[s], acc, 0, 0, 0);
        }
        st[Tt] = acc;
        if (Tt + 4 < 16 && dry != 5) DSA_LOADKT(Tt & 3, Tt + 4); }
    DSA_LOADVH(vb2, 1);
    const int rho = i16 >> 2; const bool is1 = rho == 1, is2 = rho == 2, is3 = rho == 3;
    f32x4 sv[4];
#pragma unroll
    for (int j = 0; j < 4; ++j) { const int tb = 8 * (j >> 1) + (j & 1);
#pragma unroll
        for (int c = 0; c < 4; ++c) { float x = st[tb][c]; x = is1 ? st[tb + 2][c] : x; x = is2 ? st[tb + 4][c] : x; x = is3 ? st[tb + 6][c] : x; sv[j][c] = x; } }
    float mx = -1e30f;
#pragma unroll
    for (int j = 0; j < 4; ++j) { const int Tt = 8 * (j >> 1) + (j & 1) + 2 * rho; const u16x4 kp4 = *(const LAS u16x4*)(idx + 16 * Tt + 4 * kg);
#pragma unroll
        for (int r = 0; r < 4; ++r) { const int li = 16 * Tt + 4 * kg + r; float v = sv[j][r] - slope2 * (float)(t - (int)kp4[r]); v = (li < nsel) ? v : -1e30f; sv[j][r] = v; mx = fmaxf(mx, v); } }
    mx = fmaxf(mx, __shfl_xor(mx, 4)); mx = fmaxf(mx, __shfl_xor(mx, 8)); mx = fmaxf(mx, __shfl_xor(mx, 16)); mx = fmaxf(mx, __shfl_xor(mx, 32));
    float l_run = 0.f;
#pragma unroll
    for (int j = 0; j < 4; ++j)
#pragma unroll
        for (int r = 0; r < 4; ++r) { const float p = __builtin_amdgcn_exp2f(sv[j][r] - mx); sv[j][r] = p; l_run += p; }
    const u32x4 pwA = (u32x4){cvt_pk_bf16(sv[0][0], sv[0][1]), cvt_pk_bf16(sv[0][2], sv[0][3]), cvt_pk_bf16(sv[1][0], sv[1][1]), cvt_pk_bf16(sv[1][2], sv[1][3])};
    const u32x4 pwB = (u32x4){cvt_pk_bf16(sv[2][0], sv[2][1]), cvt_pk_bf16(sv[2][2], sv[2][3]), cvt_pk_bf16(sv[3][0], sv[3][1]), cvt_pk_bf16(sv[3][2], sv[3][3])};
    if (dry == 4) {
        asm volatile("" :: "v"(pwA), "v"(pwB));
#pragma unroll
        for (int i = 0; i < 8; ++i) { asm volatile("" :: "v"(va[i])); asm volatile("" :: "v"(vb2[i])); }
        asm volatile("" :: "v"(l_run));
        return;
    }
    f32x4 o[8];
#pragma unroll
    for (int n = 0; n < 8; ++n) o[n] = (f32x4){0.f, 0.f, 0.f, 0.f};
#pragma unroll
    for (int u = 0; u < 8; ++u) {
        if (u & 1) {
#pragma unroll
            for (int i = 0; i < 8; ++i) *(LAS u32x4*)(vst + (4 * i + kg) * VROW + i16 * 16) = vb2[i];
            if (u + 2 < 8) DSA_LOADVH(vb2, u + 2);
        } else {
#pragma unroll
            for (int i = 0; i < 8; ++i) *(LAS u32x4*)(vst + (4 * i + kg) * VROW + i16 * 16) = va[i];
            if (u + 2 < 8) DSA_LOADVH(va, u + 2);
        }
        const u32x4 pws = (u < 4) ? pwA : pwB; const bool mine = rho == (u & 3);
        const u32x4 pw = (u32x4){mine ? pws[0] : 0u, mine ? pws[1] : 0u, mine ? pws[2] : 0u, mine ? pws[3] : 0u};
        const bf16x8 pa = __builtin_bit_cast(bf16x8, pw);
        asm volatile("s_waitcnt lgkmcnt(0)" ::: "memory");
#pragma unroll
        for (int n = 0; n < 8; ++n) {
            const s16x4 lo_ = __builtin_bit_cast(s16x4, __builtin_amdgcn_ds_read_tr16_b64_v4i16((LAS s16x4*)(vrd + 32 * n)));
            const s16x4 hi_ = __builtin_bit_cast(s16x4, __builtin_amdgcn_ds_read_tr16_b64_v4i16((LAS s16x4*)(vrd + 32 * n + 16 * VROW)));
            const bf16x8 vf = (bf16x8){lo_[0], lo_[1], lo_[2], lo_[3], hi_[0], hi_[1], hi_[2], hi_[3]};
            o[n] = __builtin_amdgcn_mfma_f32_16x16x32_bf16(pa, vf, o[n], 0, 0, 0); }
        asm volatile("s_waitcnt lgkmcnt(0)" ::: "memory");
    }
#undef DSA_LOADKT
#undef DSA_LOADVH
    l_run += __shfl_xor(l_run, 4); l_run += __shfl_xor(l_run, 8); l_run += __shfl_xor(l_run, 16); l_run += __shfl_xor(l_run, 32);
    const float lsel = __shfl(l_run, kg);
    const float inv = __builtin_amdgcn_rcpf(lsel);
    const bf16* DZ = (const bf16*)(ws + WS_DZ); bf16* OD = (bf16*)(ws + WS_DQ);
    const size_t ob = row * 1024 + (size_t)(4 * g + kg) * 128 + 8 * i16;
    const u32x4 zw = *(const u32x4*)(DZ + ob);
    LAS float* ost = (LAS float*)vst + kg * 132;
#pragma unroll
    for (int n = 0; n < 8; ++n) {
        const auto r01 = __builtin_amdgcn_permlane16_swap(__float_as_uint(o[n][0]), __float_as_uint(o[n][1]), false, false);
        const auto r23 = __builtin_amdgcn_permlane16_swap(__float_as_uint(o[n][2]), __float_as_uint(o[n][3]), false, false);
        const float t01 = __uint_as_float(r01[0]) + __uint_as_float(r01[1]), t23 = __uint_as_float(r23[0]) + __uint_as_float(r23[1]);
        const auto rr_ = __builtin_amdgcn_permlane32_swap(__float_as_uint(t01), __float_as_uint(t23), false, false);
        const float ov = __uint_as_float(rr_[0]) + __uint_as_float(rr_[1]); ost[16 * n + i16] = ov * inv; }
    asm volatile("s_waitcnt lgkmcnt(0)" ::: "memory");
    const f32x4 o0 = *(const LAS f32x4*)(ost + 8 * i16), o1 = *(const LAS f32x4*)(ost + 8 * i16 + 4);
    f32x4 z0, z1; unpack8(zw, z0, z1);
    const u32x4 pk = pack8(o0 * z0, o1 * z1);
    if (!dry) *(u32x4*)(OD + ob) = pk; else asm volatile("" :: "v"(pk));
    asm volatile("s_waitcnt lgkmcnt(0)" ::: "memory");
}

template <int PM>
__device__ __forceinline__ void dsa_phaseA(unsigned char* ws, LAS unsigned char* lds, int c, int G, int lane, int w, int dry) {
    for (int it = 0; it < 16; ++it) {
        const int b = it & 1, k = it >> 1;
        for (int cc = c; cc < 256; cc += G) { const int ti = 256 * k + ((k & 1) ? 255 - cc : cc);
            int nrow = -1;
            if (cc + G >= 256 && it + 1 < 16) { const int k2 = (it + 1) >> 1, ti2 = 256 * k2 + ((k2 & 1) ? 255 - c : c); if (ti2 >= 64) nrow = ((it + 1) & 1) * S + 4 * ti2; }
            if (ti >= 64) dsa_select_tile<PM>(ws, lds, b, 4 * ti, lane, w, dry, nrow); }
    }
}
__device__ __forceinline__ void dsa_phaseB(unsigned char* ws, LAS unsigned char* lds, int vcu, int G, int lane, int w, int dry) {
    LAS unsigned char* ldw = lds + w * LB_WAVE;
    unsigned* heads = (unsigned*)(ws + WS_CTL) + CW_Q0 + (dry ? 8 * 64 : 0);
    const int myshard = (G == 256) ? (vcu >> 5) : (vcu & 7);
    for (int round = 0; round < 8; ++round) { const int sh = (myshard + round) & 7;
        for (;;) { unsigned base = 0u; if (lane == 0) base = __hip_atomic_fetch_add(heads + sh * 64, (unsigned)DSA_BATCH, __ATOMIC_RELAXED, __HIP_MEMORY_SCOPE_AGENT);
            base = (unsigned)__builtin_amdgcn_readfirstlane((int)base); if (base >= 4096u) break;
            const int it0 = sh * 4096 + (int)base; u32x2 idxreg = (u32x2){0u, 0u};
            if ((it0 & (S - 1)) >= 256) idxreg = *(const u32x2*)((const unsigned short*)(ws + WS_GIDX) + ((size_t)(it0 >> 14) * S + (it0 & (S - 1))) * 256 + 4 * lane);
            for (int k = 0; k < DSA_BATCH; ++k) { const int item = it0 + k, nxt = (k < DSA_BATCH - 1) ? item + 1 : -1;
                dsa_attn_item(ws, ldw, item >> 14, (item >> 13) & 1, item & (S - 1), lane, dry, idxreg, nxt >> 14, (nxt >> 13) & 1, nxt < 0 ? 0 : (nxt & (S - 1))); } } }
}
}

namespace nsa {
typedef short s16x4 __attribute__((ext_vector_type(4)));
constexpr int L_K = 0, L_V = 32768, L_IMP = 65536, IMP_LD = 132, L_SELM = L_IMP + 64 * IMP_LD * 4, L_WS = L_SELM + 1024, L_END = L_WS + 2048;
static_assert(L_END <= 131072, "nsa LDS map");
#define NSA_KSWZ(row, colB) ((row) * 256 + ((colB) ^ (((row) & 7) << 4)))
#define NSA_SBAR() __builtin_amdgcn_sched_barrier(0)
__device__ __forceinline__ int crow(int r, int hi) { return (r & 3) + 8 * (r >> 2) + 4 * hi; }
__device__ __forceinline__ int v_st(int k, int c) { const int kk = (k & ~0xC) | ((k & 4) << 1) | ((k & 8) >> 1); return ((kk >> 3) * 4 + (c >> 5)) * 512 + ((kk & 7) * 32 + (c & 31)) * 2; }
__device__ __forceinline__ int v_rd_base(int lane) { return ((lane & 3) << 3) | (((lane >> 2) & 3) << 6) | (((lane >> 4) & 1) << 5) | (((lane >> 5) & 1) << 8); }
constexpr int v_rd_off(int d0, int ks, int half) { return d0 * 512 + ks * 4096 + half * 2048; }
template <int OFF> __device__ __forceinline__ s16x4 tr_read(int vb) { s16x4 r; asm volatile("ds_read_b64_tr_b16 %0, %1 offset:%2" : "=&v"(r) : "v"(vb), "i"(OFF) : "memory"); return r; }
template <int D0> __device__ __forceinline__ void pv_one(f32x16& od, int vb, bf16x8 pa0, bf16x8 pa1, bf16x8 pa2, bf16x8 pa3) {
    const s16x4 l0 = tr_read<v_rd_off(D0, 0, 0)>(vb), h0 = tr_read<v_rd_off(D0, 0, 1)>(vb), l1 = tr_read<v_rd_off(D0, 1, 0)>(vb), h1 = tr_read<v_rd_off(D0, 1, 1)>(vb);
    const s16x4 l2 = tr_read<v_rd_off(D0, 2, 0)>(vb), h2 = tr_read<v_rd_off(D0, 2, 1)>(vb), l3 = tr_read<v_rd_off(D0, 3, 0)>(vb), h3 = tr_read<v_rd_off(D0, 3, 1)>(vb);
    asm volatile("s_waitcnt lgkmcnt(0)" ::: "memory"); NSA_SBAR();
#define NSA_PK(L, H) (bf16x8){L[0], L[1], L[2], L[3], H[0], H[1], H[2], H[3]}
    od = __builtin_amdgcn_mfma_f32_32x32x16_bf16(pa0, NSA_PK(l0, h0), od, 0, 0, 0);
    od = __builtin_amdgcn_mfma_f32_32x32x16_bf16(pa1, NSA_PK(l1, h1), od, 0, 0, 0);
    od = __builtin_amdgcn_mfma_f32_32x32x16_bf16(pa2, NSA_PK(l2, h2), od, 0, 0, 0);
    od = __builtin_amdgcn_mfma_f32_32x32x16_bf16(pa3, NSA_PK(l3, h3), od, 0, 0, 0);
#undef NSA_PK
}
__device__ __forceinline__ void pv_all(f32x16* o, int vb, bf16x8 pa0, bf16x8 pa1, bf16x8 pa2, bf16x8 pa3) {
    pv_one<0>(o[0], vb, pa0, pa1, pa2, pa3); pv_one<1>(o[1], vb, pa0, pa1, pa2, pa3); pv_one<2>(o[2], vb, pa0, pa1, pa2, pa3); pv_one<3>(o[3], vb, pa0, pa1, pa2, pa3);
}
__device__ __forceinline__ void qkt(f32x16& p0, f32x16& p1, const LAS unsigned char* Ks, const bf16x8* qr, int r32, int hi) {
    p0 = f32x16{}; p1 = f32x16{};
#pragma unroll
    for (int d0 = 0; d0 < 8; ++d0) { const int cb = (d0 * 16 + hi * 8) * 2;
        const bf16x8 b0 = *(const LAS bf16x8*)(Ks + NSA_KSWZ(r32, cb));
        const bf16x8 b1 = *(const LAS bf16x8*)(Ks + NSA_KSWZ(32 + r32, cb));
        p0 = __builtin_amdgcn_mfma_f32_32x32x16_bf16(b0, qr[d0], p0, 0, 0, 0);
        p1 = __builtin_amdgcn_mfma_f32_32x32x16_bf16(b1, qr[d0], p1, 0, 0, 0); }
}
__device__ __forceinline__ void pack_p(const f32x16& p0, const f32x16& p1, bf16x8& pa0, bf16x8& pa1, bf16x8& pa2, bf16x8& pa3) {
#define NSA_PK4(P, BASE, OUT) do { const unsigned a0 = cvt_pk_bf16(P[BASE + 0], P[BASE + 1]), a1 = cvt_pk_bf16(P[BASE + 2], P[BASE + 3]);   \
    const unsigned b0 = cvt_pk_bf16(P[BASE + 4], P[BASE + 5]), b1 = cvt_pk_bf16(P[BASE + 6], P[BASE + 7]);                              \
    const auto r0 = __builtin_amdgcn_permlane32_swap(a0, b0, false, false); const auto r1 = __builtin_amdgcn_permlane32_swap(a1, b1, false, false); \
    const u32x4 w_ = {r0[0], r1[0], r0[1], r1[1]}; OUT = __builtin_bit_cast(bf16x8, w_); } while (0)
    NSA_PK4(p0, 0, pa0); NSA_PK4(p0, 8, pa1); NSA_PK4(p1, 0, pa2); NSA_PK4(p1, 8, pa3);
#undef NSA_PK4
}
__device__ __forceinline__ float row_max(const f32x16& p0, const f32x16& p1) {
    float m = p0[0];
#pragma unroll
    for (int r = 1; r < 16; ++r) m = fmaxf(m, p0[r]);
#pragma unroll
    for (int r = 0; r < 16; ++r) m = fmaxf(m, p1[r]);
    const auto rr = __builtin_amdgcn_permlane32_swap(__float_as_uint(m), __float_as_uint(m), false, false);
    return fmaxf(__uint_as_float(rr[0]), __uint_as_float(rr[1]));
}
__device__ __forceinline__ float row_sum(const f32x16& p0, const f32x16& p1) {
    float s = 0.f;
#pragma unroll
    for (int r = 0; r < 16; ++r) s += p0[r];
#pragma unroll
    for (int r = 0; r < 16; ++r) s += p1[r];
    const auto rr = __builtin_amdgcn_permlane32_swap(__float_as_uint(s), __float_as_uint(s), false, false);
    return __uint_as_float(rr[0]) + __uint_as_float(rr[1]);
}
__device__ __forceinline__ int next_bit(unsigned long long lo, unsigned long long hi, int from) {
    if (from < 64) { const unsigned long long v = lo >> from; if (v) return from + (__ffsll((long long)v) - 1); from = 64; }
    if (from < 128) { const unsigned long long v = hi >> (from - 64); if (v) return from + (__ffsll((long long)v) - 1); }
    return -1;
}

struct Stg { u32x4 k0, k1, v0, v1; };

__device__ __forceinline__ void nsa_unit(unsigned char* ws, LAS unsigned char* lds, const int b, const int g, const int qb, const int tid_in, const int lane_in, const int w_in, const int dry) {
    int w = w_in; asm volatile("" : "+s"(w));
    int lane = lane_in; asm volatile("" : "+v"(lane));
    const int tid = w * 64 + lane; (void)tid_in;
    const int r32 = lane & 31, hi = lane >> 5, ql = r32 >> 2, j = r32 & 3, h = 4 * g + j;
    const int toff = 8 * w + ql, tq = 64 * qb + toff;
    const size_t row = (size_t)b * S + tq;
    const int bg = b * 2 + g;
    LAS float* IMP = (LAS float*)(lds + L_IMP); LAS unsigned* SELM = (LAS unsigned*)(lds + L_SELM);
    LAS float* wsf = (LAS float*)(lds + L_WS) + w * 64;
    const float slope2 = __builtin_amdgcn_exp2f(-(float)(h + 1)) * LOG2E;
    bf16x8 qr[8];
    { const bf16* Qp = (const bf16*)(ws + WS_QN) + row * 1024 + h * 128 + hi * 8;
#pragma unroll
      for (int d0 = 0; d0 < 8; ++d0) qr[d0] = *(const bf16x8*)(Qp + d0 * 16); }
    const int sr = tid >> 4, sc = (tid & 15) * 8;
    const int vst0 = v_st(sr, sc), vst1 = v_st(32 + sr, sc), kst0 = NSA_KSWZ(sr, sc * 2), kst1 = NSA_KSWZ(32 + sr, sc * 2);
    const int vb0 = (int)(uintptr_t)(lds + L_V) + v_rd_base(lane);
    float* ACCw = (float*)(ws + WS_XB) + ((size_t)((bg * 128 + qb) * 8 + w)) * 4096 + lane;
    const float* MS = (const float*)(ws + WS_MISC);
    const size_t obase = ((size_t)b * S + 64 * qb + 8 * w + hi) * 1024 + (size_t)(4 * g) * 128 + r32;
    const size_t gbase = ((size_t)b * S + 64 * qb + 8 * w + hi) * 40 + 16 + (size_t)(4 * g) * 3;

    for (int i = tid; i < 64 * IMP_LD; i += NTHR) IMP[i] = 0.f;

    Stg st;
#define NSA_SLOAD(KP, VP) do { const bf16* kp_ = (KP); const bf16* vp_ = (VP); \
        st.k0 = *(const u32x4*)(kp_ + (size_t)sr * 128 + sc); st.k1 = *(const u32x4*)(kp_ + (size_t)(32 + sr) * 128 + sc); \
        st.v0 = *(const u32x4*)(vp_ + (size_t)sr * 128 + sc); st.v1 = *(const u32x4*)(vp_ + (size_t)(32 + sr) * 128 + sc); } while (0)
#define NSA_SWRITE(bufi) do { LAS unsigned char* kb_ = lds + L_K + (bufi) * 16384; LAS unsigned char* vb_ = lds + L_V + (bufi) * 16384; \
        *(LAS u32x4*)(kb_ + kst0) = st.k0; *(LAS u32x4*)(kb_ + kst1) = st.k1; *(LAS u32x4*)(vb_ + vst0) = st.v0; *(LAS u32x4*)(vb_ + vst1) = st.v1; } while (0)
#define NSA_MASK(P0, P1, LO, HI, SL, SB) do { int lo_ = (LO), hi_ = (HI); float sl_ = (SL), sb_ = (SB); asm volatile("" : "+v"(lo_), "+v"(hi_), "+v"(sl_), "+v"(sb_)); \
        if (__all(lo_ < 0 && hi_ >= 59)) {                   \
            _Pragma("unroll") for (int r_ = 0; r_ < 16; ++r_) { const int c0_ = (r_ & 3) + 8 * (r_ >> 2), c1_ = c0_ + 32; \
                P0[r_] = P0[r_] + fmaf(sl_, (float)c0_, sb_); P1[r_] = P1[r_] + fmaf(sl_, (float)c1_, sb_); } \
        } else { \
        _Pragma("unroll") for (int r_ = 0; r_ < 16; ++r_) { const int c0_ = (r_ & 3) + 8 * (r_ >> 2), c1_ = c0_ + 32; \
            P0[r_] = (c0_ > lo_ && c0_ <= hi_) ? P0[r_] + fmaf(sl_, (float)c0_, sb_) : -INFINITY; \
            P1[r_] = (c1_ > lo_ && c1_ <= hi_) ? P1[r_] + fmaf(sl_, (float)c1_, sb_) : -INFINITY; } } } while (0)
#define NSA_ONLINE(P0, P1) do { const float pm_ = row_max(P0, P1); const float mn_ = (pm_ > m_run + 8.0f) ? pm_ : m_run; const float al_ = __builtin_amdgcn_exp2f(m_run - mn_); m_run = mn_; \
        _Pragma("unroll") for (int r_ = 0; r_ < 16; ++r_) { P0[r_] = __builtin_amdgcn_exp2f(P0[r_] - mn_); P1[r_] = __builtin_amdgcn_exp2f(P1[r_] - mn_); } \
        l_run = l_run * al_ + row_sum(P0, P1); \
        if (__any(al_ < 1.f)) { if (hi == 0) wsf[r32] = al_; asm volatile("s_waitcnt lgkmcnt(0)" ::: "memory"); \
            _Pragma("unroll") for (int r_ = 0; r_ < 16; ++r_) { const float f_ = wsf[crow(r_, hi)]; o[0][r_] *= f_; o[1][r_] *= f_; o[2][r_] *= f_; o[3][r_] *= f_; } } } while (0)

    f32x16 o[4]; f32x16 p0, p1; bf16x8 pa0, pa1, pa2, pa3;
    float m_run, l_run;

    const bf16* KCp = (const bf16*)(ws + WS_KC) + (size_t)bg * 512 * 128; const bf16* VCp = (const bf16*)(ws + WS_VC) + (size_t)bg * 512 * 128;
    const int ntc = ((4 * qb + 2) >> 6) + 1;
    const int nmax = (tq - 31) >> 4;
    const float tqc = (float)tq - 15.5f;
    m_run = -1e30f; l_run = 0.f;
    NSA_SLOAD(KCp, VCp); __syncthreads(); NSA_SWRITE(0); __syncthreads();
    for (int tc = 0; tc < ntc; ++tc) {
        if (tc + 1 < ntc) NSA_SLOAD(KCp + (size_t)(tc + 1) * 64 * 128, VCp + (size_t)(tc + 1) * 64 * 128);
        qkt(p0, p1, lds + L_K + (tc & 1) * 16384, qr, r32, hi);
        NSA_MASK(p0, p1, -1, nmax - 64 * tc - 4 * hi, 16.f * slope2, slope2 * ((float)(16 * (64 * tc + 4 * hi)) - tqc));
        { const float pm = row_max(p0, p1); const float mn = fmaxf(m_run, pm); const float al = __builtin_amdgcn_exp2f(m_run - mn); m_run = mn;
#pragma unroll
          for (int r = 0; r < 16; ++r) { p0[r] = __builtin_amdgcn_exp2f(p0[r] - mn); p1[r] = __builtin_amdgcn_exp2f(p1[r] - mn); }
          l_run = l_run * al + row_sum(p0, p1); }
        if (tc + 1 < ntc) NSA_SWRITE((tc + 1) & 1);
        __syncthreads();
    }
    {
        const float invl = l_run > 0.f ? 1.0f / l_run : 0.f;
#pragma unroll
        for (int d = 0; d < 4; ++d) o[d] = f32x16{};
        NSA_SLOAD(KCp, VCp); NSA_SWRITE(0); __syncthreads();
        for (int tc = 0; tc < ntc; ++tc) {
            if (tc + 1 < ntc) NSA_SLOAD(KCp + (size_t)(tc + 1) * 64 * 128, VCp + (size_t)(tc + 1) * 64 * 128);
            qkt(p0, p1, lds + L_K + (tc & 1) * 16384, qr, r32, hi);
            NSA_MASK(p0, p1, -1, nmax - 64 * tc - 4 * hi, 16.f * slope2, slope2 * ((float)(16 * (64 * tc + 4 * hi)) - tqc));
#pragma unroll
            for (int r = 0; r < 16; ++r) { p0[r] = __builtin_amdgcn_exp2f(p0[r] - m_run) * invl; p1[r] = __builtin_amdgcn_exp2f(p1[r] - m_run) * invl; }
#pragma unroll
            for (int hf = 0; hf < 2; ++hf)
#pragma unroll
                for (int a4 = 0; a4 < 4; ++a4) {
                    const float x0 = hf ? p1[4 * a4] : p0[4 * a4], x1 = hf ? p1[4 * a4 + 1] : p0[4 * a4 + 1], x2 = hf ? p1[4 * a4 + 2] : p0[4 * a4 + 2], x3 = hf ? p1[4 * a4 + 3] : p0[4 * a4 + 3];
                    float mainv = (x0 + x1) + (x2 + 0.5f * x3), carry = 0.5f * x3;
                    mainv += __shfl_xor(mainv, 1); mainv += __shfl_xor(mainv, 2); carry += __shfl_xor(carry, 1); carry += __shfl_xor(carry, 2);
                    const int mb = 16 * tc + 8 * hf + 2 * a4 + hi;
                    if (j == 0) { (void)__hip_atomic_fetch_add(IMP + toff * IMP_LD + mb, mainv, __ATOMIC_RELAXED, __HIP_MEMORY_SCOPE_WORKGROUP);
                                  (void)__hip_atomic_fetch_add(IMP + toff * IMP_LD + mb + 1, carry, __ATOMIC_RELAXED, __HIP_MEMORY_SCOPE_WORKGROUP); }
                }
            pack_p(p0, p1, pa0, pa1, pa2, pa3);
            pv_all(o, vb0 + (tc & 1) * 16384, pa0, pa1, pa2, pa3);
            if (tc + 1 < ntc) NSA_SWRITE((tc + 1) & 1);
            __syncthreads();
        }
        { size_t gb = gbase; float* ab = ACCw; asm volatile("" : "+v"(gb), "+v"(ab));
          float gt[16];
#pragma unroll
          for (int r = 0; r < 16; ++r) gt[r] = MS[gb + (2 * (r >> 2)) * 40 + (r & 3) * 3 + 0];
#pragma unroll
          for (int r = 0; r < 16; ++r) { const float g_ = sigmoidf_(gt[r]);
#pragma unroll
              for (int d0 = 0; d0 < 4; ++d0) ab[(r * 4 + d0) * 64] = g_ * o[d0][r]; } }
    }
    if (dry == 2) { __syncthreads(); return; }
    {
        const int q = tid >> 3, mt = tid & 7;
        unsigned mk0 = 0u, mk1 = 0u, mk2 = 0u, mk3 = 0u;
        if (qb < 16) { mk0 = (2u << qb) - 1u; }
        else {
            unsigned key[16];
#pragma unroll
            for (int k = 0; k < 16; ++k) { const int m = mt + 8 * k; const bool cand = (m >= 1) && (m <= qb - 2); const unsigned raw = __float_as_uint(IMP[q * IMP_LD + m]) + 1u;
                key[k] = cand ? raw : 0u; }
            unsigned ans = 0u;
            for (int bit = 30; bit >= 0; --bit) { const unsigned trial = ans | (1u << bit); int c = 0;
#pragma unroll
                for (int k = 0; k < 16; ++k) c += (key[k] >= trial) ? 1 : 0;
                c = sum8_dpp(c);
                if (c >= 13) ans = trial; }
            int cg = 0;
#pragma unroll
            for (int k = 0; k < 16; ++k) cg += (key[k] > ans) ? 1 : 0;
            cg = sum8_dpp(cg);
            const int rtake = 13 - cg; int run = 0;
#pragma unroll
            for (int k = 0; k < 16; ++k) { const bool tie = key[k] == ans && ans != 0u; const unsigned long long bal = __ballot(tie);
                const unsigned grp = (unsigned)(bal >> (8 * (lane >> 3))) & 0xffu; const int before = __popc(grp & ((1u << mt) - 1u));
                const bool take = (key[k] > ans) || (tie && (run + before) < rtake);
                run += __popc(grp);
                const unsigned bitv = take ? (1u << (8 * (k & 3) + mt)) : 0u;
                if ((k >> 2) == 0) mk0 |= bitv; else if ((k >> 2) == 1) mk1 |= bitv; else if ((k >> 2) == 2) mk2 |= bitv; else mk3 |= bitv; }
            mk0 |= 1u;
            { const int f1 = qb - 1, f2 = qb; const unsigned b1 = 1u << (f1 & 31), b2 = 1u << (f2 & 31);
              if ((f1 >> 5) == 0) mk0 |= b1; else if ((f1 >> 5) == 1) mk1 |= b1; else if ((f1 >> 5) == 2) mk2 |= b1; else mk3 |= b1;
              if ((f2 >> 5) == 0) mk0 |= b2; else if ((f2 >> 5) == 1) mk1 |= b2; else if ((f2 >> 5) == 2) mk2 |= b2; else mk3 |= b2; }
            mk0 |= __shfl_xor(mk0, 1); mk0 |= __shfl_xor(mk0, 2); mk0 |= __shfl_xor(mk0, 4);
            mk1 |= __shfl_xor(mk1, 1); mk1 |= __shfl_xor(mk1, 2); mk1 |= __shfl_xor(mk1, 4);
            mk2 |= __shfl_xor(mk2, 1); mk2 |= __shfl_xor(mk2, 2); mk2 |= __shfl_xor(mk2, 4);
            mk3 |= __shfl_xor(mk3, 1); mk3 |= __shfl_xor(mk3, 2); mk3 |= __shfl_xor(mk3, 4);
        }
        if (mt == 0) *(LAS u32x4*)(SELM + q * 4) = (u32x4){mk0, mk1, mk2, mk3};
    }
    __syncthreads();
    unsigned long long um_lo, um_hi; u32x4 mysel;
    { u32x4 x = *(const LAS u32x4*)(SELM + lane * 4);
#pragma unroll
      for (int o_ = 1; o_ < 64; o_ <<= 1) { x.x |= __shfl_xor(x.x, o_); x.y |= __shfl_xor(x.y, o_); x.z |= __shfl_xor(x.z, o_); x.w |= __shfl_xor(x.w, o_); }
      um_lo = ((unsigned long long)(unsigned)__builtin_amdgcn_readfirstlane((int)x.y) << 32) | (unsigned)__builtin_amdgcn_readfirstlane((int)x.x);
      um_hi = ((unsigned long long)(unsigned)__builtin_amdgcn_readfirstlane((int)x.w) << 32) | (unsigned)__builtin_amdgcn_readfirstlane((int)x.z);
      mysel = *(const LAS u32x4*)(SELM + toff * 4); }
    const unsigned long long my_lo = ((unsigned long long)mysel.y << 32) | mysel.x, my_hi = ((unsigned long long)mysel.w << 32) | mysel.z;

    if (dry == 3) { asm volatile("" :: "v"(my_lo), "v"(my_hi)); __syncthreads(); return; }
    {
        const bf16* KSp = (const bf16*)(ws + WS_KS) + (size_t)bg * S * 128; const bf16* VSp = (const bf16*)(ws + WS_VS) + (size_t)bg * S * 128;
        m_run = -1e30f; l_run = 0.f;
#pragma unroll
        for (int d = 0; d < 4; ++d) o[d] = f32x16{};
        int m = next_bit(um_lo, um_hi, 0), it = 0;
        NSA_SLOAD(KSp + (size_t)m * 64 * 128, VSp + (size_t)m * 64 * 128); NSA_SWRITE(0); __syncthreads();
        while (m >= 0) {
            const int mn2 = next_bit(um_lo, um_hi, m + 1);
            if (mn2 >= 0) NSA_SLOAD(KSp + (size_t)mn2 * 64 * 128, VSp + (size_t)mn2 * 64 * 128);
            const bool selb = (m < 64) ? ((my_lo >> m) & 1ull) != 0ull : ((my_hi >> (m - 64)) & 1ull) != 0ull;
            if (__any(selb)) {
                qkt(p0, p1, lds + L_K + (it & 1) * 16384, qr, r32, hi);
                NSA_MASK(p0, p1, -1, selb ? (tq - 64 * m - 4 * hi) : -1, slope2, slope2 * (float)(64 * m + 4 * hi - tq));
                NSA_ONLINE(p0, p1);
                pack_p(p0, p1, pa0, pa1, pa2, pa3);
                pv_all(o, vb0 + (it & 1) * 16384, pa0, pa1, pa2, pa3);
            }
            if (mn2 >= 0) NSA_SWRITE((it + 1) & 1);
            __syncthreads();
            m = mn2; ++it;
        }
        if (hi == 0) wsf[32 + r32] = l_run; asm volatile("s_waitcnt lgkmcnt(0)" ::: "memory");
        { size_t gb = gbase; float* ab = ACCw; asm volatile("" : "+v"(gb), "+v"(ab));
          float gt[16];
#pragma unroll
          for (int r = 0; r < 16; ++r) gt[r] = MS[gb + (2 * (r >> 2)) * 40 + (r & 3) * 3 + 1];
#pragma unroll
          for (int r = 0; r < 16; ++r) { const float sc_ = sigmoidf_(gt[r]) * __builtin_amdgcn_rcpf(wsf[32 + crow(r, hi)]);
#pragma unroll
              for (int d0 = 0; d0 < 4; ++d0) ab[(r * 4 + d0) * 64] += sc_ * o[d0][r]; } }
    }
    if (dry == 4) { __syncthreads(); return; }
    {
        const bf16* KWp = (const bf16*)(ws + WS_KW) + (size_t)bg * S * 128; const bf16* VWp = (const bf16*)(ws + WS_VW) + (size_t)bg * S * 128;
        m_run = -1e30f; l_run = 0.f;
#pragma unroll
        for (int d = 0; d < 4; ++d) o[d] = f32x16{};
        const int m0 = qb >= 8 ? qb - 8 : 0;
        __syncthreads();
        NSA_SLOAD(KWp + (size_t)m0 * 64 * 128, VWp + (size_t)m0 * 64 * 128); NSA_SWRITE(0); __syncthreads();
        for (int m = m0, it = 0; m <= qb; ++m, ++it) {
            if (m < qb) NSA_SLOAD(KWp + (size_t)(m + 1) * 64 * 128, VWp + (size_t)(m + 1) * 64 * 128);
            qkt(p0, p1, lds + L_K + (it & 1) * 16384, qr, r32, hi);
            NSA_MASK(p0, p1, tq - 512 - 64 * m - 4 * hi, tq - 64 * m - 4 * hi, slope2, slope2 * (float)(64 * m + 4 * hi - tq));
            NSA_ONLINE(p0, p1);
            pack_p(p0, p1, pa0, pa1, pa2, pa3);
            pv_all(o, vb0 + (it & 1) * 16384, pa0, pa1, pa2, pa3);
            if (m < qb) NSA_SWRITE((it + 1) & 1);
            __syncthreads();
        }
        if (hi == 0) wsf[32 + r32] = l_run; asm volatile("s_waitcnt lgkmcnt(0)" ::: "memory");
        const bf16* NZ = (const bf16*)(ws + WS_NZ); bf16* ON = (bf16*)(ws + WS_QN);
        { size_t gb = gbase, ob = obase; const float* ab = ACCw; asm volatile("" : "+v"(gb), "+v"(ab), "+v"(ob));
          float gt[16];
#pragma unroll
          for (int r = 0; r < 16; ++r) gt[r] = MS[gb + (2 * (r >> 2)) * 40 + (r & 3) * 3 + 2];
#pragma unroll
          for (int r = 0; r < 16; ++r) { const float sc_ = sigmoidf_(gt[r]) * __builtin_amdgcn_rcpf(wsf[32 + crow(r, hi)]);
              const size_t orow = ob + (2 * (r >> 2)) * 1024 + (r & 3) * 128;
#pragma unroll
              for (int d0 = 0; d0 < 4; ++d0) { const float z = __uint_as_float((unsigned)NZ[orow + 32 * d0] << 16);
                  const unsigned ov_ = cvt_pk_bf16((ab[(r * 4 + d0) * 64] + sc_ * o[d0][r]) * z, 0.f);
                  if (!dry) ON[orow + 32 * d0] = (bf16)(ov_ & 0xffffu); else asm volatile("" :: "v"(ov_)); } } }
    }
    __syncthreads();
#undef NSA_SLOAD
#undef NSA_SWRITE
#undef NSA_MASK
#undef NSA_ONLINE
}

__device__ __forceinline__ void nsa_phase(unsigned char* ws, LAS unsigned char* lds, int c, int G, int tid, int lane, int w, int dry) {
    for (int cc = c; cc < 256; cc += G) { const int bgi = cc >> 6, s = cc & 63;
        nsa_unit(ws, lds, bgi >> 1, bgi & 1, 127 - s, tid, lane, w, dry);
        nsa_unit(ws, lds, bgi >> 1, bgi & 1, s, tid, lane, w, dry); }
}
#undef NSA_KSWZ
#undef NSA_SBAR
}

#ifndef REPC2
#define REPC2 1
#endif
#ifndef REP3BMODE
#define REP3BMODE 1
#endif
#ifndef REP4MODE
#define REP4MODE 1
#endif
#ifndef REP0
#define REP0 1
#endif
#ifndef REP1
#define REP1 1
#endif
#ifndef REP3
#define REP3 1
#endif
#ifndef REP3B
#define REP3B 1
#endif
#ifndef REP3PM
#define REP3PM 0
#endif
#ifndef REP3MODE
#define REP3MODE 1
#endif
#ifndef REP4
#define REP4 1
#endif
#ifndef REP5
#define REP5 1
#endif
constexpr int N_PHASES = 8;
__global__ void __launch_bounds__(NTHR, 2) fwd_kernel(Args args) {
    extern __shared__ __attribute__((aligned(16))) unsigned char lds_raw[];
    Frame F;
    F.lds = (LAS unsigned char*)lds_raw;
    F.wave = __builtin_amdgcn_readfirstlane((int)threadIdx.x >> 6);
    F.G = gridDim.x; { const int bx = blockIdx.x; F.vcu = (F.G % 8 == 0) ? (bx % 8) * (F.G / 8) + bx / 8 : bx; }
    unsigned char* ws = args.ws;
    gu32* ctl = (gu32*)(ws + WS_CTL);
    volatile LAS unsigned* MISC = (volatile LAS unsigned*)(F.lds + MISC_OFF);
    for (int u = (F.wave * 64 + lane_id()); u < (LDS_BYTES - LDSCTL_OFF) / 4; u += NTHR) ((LAS unsigned*)(F.lds + LDSCTL_OFF))[u] = 0u;
    __syncthreads();
    const int lo = args.ph_lo, hi = args.ph_hi;
    const bool multi = (hi - lo) > 1;
    XcdBarrier bar; bar.bar = (unsigned*)(ctl + CW_BAR); bar.x = 0; bar.st = nullptr; bar.wave = F.wave;
    if (multi) bar = xcd_barrier_post((unsigned*)(ctl + CW_BAR), MISC + 8, F.wave);
#define IN(k) (lo <= (k) && (k) < hi)
#define SEAM(k) do { if (IN(k) && IN((k) + 1)) xcd_barrier(bar); } while (0)
    bf16* MGN = (bf16*)args.out; bf16* MGD = MGN + (size_t)T * DM;
    const int bx = (int)blockIdx.x;

    if (IN(0)) { for (int rep = 0; rep < REP0; ++rep) p0_prologue(F, args); }
    SEAM(0);
    if (IN(1)) {
        { SchedPlain Sd; Sd.to.init(T / 256, NPAD / 256 - 1, WGM_INPROJ); Sd.G = F.G; Sd.c = bx;     Sd.A = (const char*)(ws + WS_XB); Sd.B = (const char*)(ws + WS_WIN); Sd.at = (size_t)256 * DM * 2; Sd.bt = (size_t)256 * DM * 2;
          EpiInProj E{ws, MGN, MGD, (LAS float*)(F.lds + LDSCTL_OFF + 2048)};
          for (int rep = 0; rep < REP1; ++rep) pg8::gemm_phase<DM, DM, DM>(F.lds + RING_OFF, F.wave, Sd, E); }
        { SchedTail St; St.G = F.G; St.c = bx; St.A = (const char*)(ws + WS_XB); St.B = (const char*)(ws + WS_WIN) + (size_t)44 * 256 * DM * 2; St.at = (size_t)256 * DM * 2;
          EpiMisc Em{ws};
          pg8::gemm_phase<DM, DM, DM, EpiMisc, SchedTail, true>(F.lds + RING_OFF, F.wave, St, Em); }
        { SchedPlain Sd; Sd.to.init(T / 256, DM / 256); const int nfull = (T / 256) % F.G;
          Sd.G = F.G - nfull; Sd.c = bx - nfull; if (Sd.G <= 0) { Sd.G = F.G; Sd.c = bx; }
          Sd.A = (const char*)(ws + WS_PB); Sd.B = (const char*)(ws + WS_WPP); Sd.at = (size_t)256 * 256 * 2; Sd.bt = (size_t)256 * 256 * 2;
          EpiBf16Plain E{(bf16*)(ws + WS_PP), DM};
          pg8::gemm_phase<256, 256, 256>(F.lds + RING_OFF, F.wave, Sd, E);
          const int ng = F.G - nfull;
          if (ng > 0 && ng < F.G) { if (bx >= nfull) tr_items(args, (LAS float*)(F.lds + RING_OFF + F.wave * 16384), TR_EARLY, TR_NITEMS, (bx - nfull) * NWAVES + F.wave, ng * NWAVES, lane_id()); }
          else tr_items(args, (LAS float*)(F.lds + RING_OFF + F.wave * 16384), TR_EARLY, TR_NITEMS, bx * NWAVES + F.wave, F.G * NWAVES, lane_id()); }
    }
    SEAM(1);
    if (IN(2)) {
        if (bx < 128) {
            SchedCmp Sd; Sd.c = bx; Sd.A0 = (const char*)(ws + WS_KCR); Sd.A1 = (const char*)(ws + WS_VCR); Sd.B0 = (const char*)(ws + WS_WC1K); Sd.B1 = (const char*)(ws + WS_WC1V);
            EpiCmp E{(float*)(ws + WS_CP4)};
            pg8::gemm_phase<512, 2048, 2048>(F.lds + RING_OFF, F.wave, Sd, E);
        }
        if (bx >= 128 || F.G <= 128) {
            const int nw = F.G > 128 ? (F.G - 128) * NWAVES : F.G * NWAVES, gw = (F.G > 128 ? bx - 128 : bx) * NWAVES + F.wave, ln = lane_id();
            const _Float16* IQh = (const _Float16*)(ws + WS_IQ); const float* MS = (const float*)(ws + WS_MISC); _Float16* QS = (_Float16*)(ws + WS_QS);
            for (int t = gw; t < T; t += nw) { float sum = 0.f;
#pragma unroll
                for (int h = 0; h < 16; ++h) { const _Float16 wq = (_Float16)(MS[(size_t)t * 40 + h] * 0.03125f); sum += (float)(IQh[(size_t)t * 1024 + h * 64 + ln] * wq); }
                sum *= 0.5f; const _Float16 hi = (_Float16)sum, lo = (_Float16)(sum - (float)hi);
                QS[(size_t)t * 128 + ln] = hi; QS[(size_t)t * 128 + 64 + ln] = lo; }
        }
        if (bx == F.G - 1) { const int idx = F.wave * 64 + lane_id(); const float* BPp = (const float*)(ws + WS_BIASP) + (idx >> 8) * 64 * 256 + (idx & 255); float sb = 0.f;
            for (int c = 0; c < 64; ++c) sb += BPp[c * 256];
            ((float*)(ws + WS_BIAS))[idx] = sb; }
    }
    SEAM(2);
    if (IN(3)) {
        LAS float* hbuf = (LAS float*)(F.lds + RING_OFF + F.wave * 4096);
        const int gw = F.vcu * NWAVES + F.wave, NGW = F.G * NWAVES;
        for (int rep = 0; rep < REPC2; ++rep) for (int task = gw; task < 1024; task += NGW) cmp2_task(args, task, hbuf, lane_id());
        __syncthreads();
        for (int rep = REP3 - 1; rep >= 0; --rep) { if (rep) dsa::dsa_phaseA<REP3PM>(ws, F.lds + RING_OFF, bx, F.G, lane_id(), F.wave, REP3MODE); else dsa::dsa_phaseA<0>(ws, F.lds + RING_OFF, bx, F.G, lane_id(), F.wave, 0); }
    }
    SEAM(3);
    if (IN(4)) {
        for (int rep = REP4 - 1; rep >= 0; --rep) nsa::nsa_phase(ws, F.lds + RING_OFF, F.vcu, F.G, (F.wave * 64 + lane_id()), lane_id(), F.wave, rep ? REP4MODE : 0);
        for (int rep = REP3B - 1; rep >= 0; --rep) dsa::dsa_phaseB(ws, F.lds + RING_OFF, F.vcu, F.G, lane_id(), F.wave, rep ? REP3BMODE : 0);
    }
    SEAM(4);
#ifdef EXTRA_BAR
    for (int eb = 0; eb < EXTRA_BAR; ++eb) xcd_barrier(bar);
#endif
    if (IN(5)) {
        SchedChain Sd; Sd.to.init(T / 256, DM / 256, WGM_OUT); Sd.G = F.G; Sd.c = bx;
        Sd.A0 = (const char*)(ws + WS_QN); Sd.B0 = (const char*)(ws + WS_WUPN); Sd.A1 = (const char*)(ws + WS_DQ); Sd.B1 = (const char*)(ws + WS_WUPD); Sd.at = (size_t)256 * 1024 * 2; Sd.bt = (size_t)256 * 1024 * 2;
        EpiY E{MGN, MGD, (bf16*)(ws + WS_XB)};
        for (int rep = 0; rep < REP5; ++rep) pg8::gemm_phase<1024, 1024, 1024>(F.lds + RING_OFF, F.wave, Sd, E);
    }
    SEAM(5);
    if (IN(6)) {
        SchedPlain Sd; Sd.to.init(T / 256, DM / 256, WGM_OUT); Sd.G = F.G; Sd.c = bx; Sd.A = (const char*)(ws + WS_XB); Sd.B = (const char*)(ws + WS_WOUT); Sd.at = (size_t)256 * DM * 2; Sd.bt = (size_t)256 * DM * 2;
        EpiX1 E{args.in[0], args.out, (bf16*)(ws + WS_X1B), (float*)(ws + WS_CTL + CTL_SS1)};
        pg8::gemm_phase<DM, DM, DM>(F.lds + RING_OFF, F.wave, Sd, E);
    }
    SEAM(6);
    if (IN(7)) {
        SchedPlain Sd; Sd.to.init(T / 256, DM / 256, WGM_OUT); Sd.G = F.G; Sd.c = bx; Sd.A = (const char*)(ws + WS_X1B); Sd.B = (const char*)(ws + WS_WG); Sd.at = (size_t)256 * DM * 2; Sd.bt = (size_t)256 * DM * 2;
        EpiFinal E{args.out, (const bf16*)(ws + WS_PP), (const float*)(ws + WS_CTL + CTL_SS1)};
        pg8::gemm_phase<DM, DM, DM>(F.lds + RING_OFF, F.wave, Sd, E);
    }
#undef IN
#undef SEAM
}

#ifndef MK_ONE_LAUNCH
#define MK_ONE_LAUNCH 1
#endif
extern "C" void kernel_launch(void* const* d_in, const int* in_sizes, int n_in, void* d_out, int out_size, void* d_ws, size_t ws_size, hipStream_t stream) {
    static int grid = 0;
    if (grid == 0) {
        if (n_in != 22 || in_sizes[0] != T * DM || out_size != T * DM || ws_size < WS_END) {
            fprintf(stderr, "kernel_launch: unexpected shapes: n_in %d in0 %d out %d ws %zu (need %zu)\n", n_in, n_in > 0 ? in_sizes[0] : -1, out_size, ws_size, (size_t)WS_END); grid = -1; return; }
        int dev = 0, cus = 0;
        if (hipGetDevice(&dev) != hipSuccess || hipDeviceGetAttribute(&cus, hipDeviceAttributeMultiprocessorCount, dev) != hipSuccess) { grid = -1; return; }
        if (hipFuncSetAttribute((const void*)fwd_kernel, hipFuncAttributeMaxDynamicSharedMemorySize, LDS_BYTES) != hipSuccess) { fprintf(stderr, "kernel_launch: hipFuncSetAttribute failed\n"); grid = -1; return; }
        int occ = 0;
        if (hipOccupancyMaxActiveBlocksPerMultiprocessor(&occ, (const void*)fwd_kernel, NTHR, LDS_BYTES) != hipSuccess || occ < 1) { fprintf(stderr, "kernel_launch: occupancy query: %d blocks per CU\n", occ); grid = -1; return; }
        (void)hipGetLastError();
        grid = cus;
    }
    if (grid < 0) return;
    if (hipMemsetAsync((char*)d_ws + WS_CTL, 0, CTL_ZERO_BYTES, stream) != hipSuccess) return;
    Args a{};
    for (int i = 0; i < 22; ++i) a.in[i] = (const float*)d_in[i];
    a.out = (float*)d_out; a.ws = (unsigned char*)d_ws;
    if (MK_ONE_LAUNCH) { a.ph_lo = 0; a.ph_hi = N_PHASES; hipLaunchKernelGGL(fwd_kernel, dim3(grid), dim3(NTHR), LDS_BYTES, stream, a); }
    else for (int p = 0; p < N_PHASES; ++p) { a.ph_lo = p; a.ph_hi = p + 1; hipLaunchKernelGGL(fwd_kernel, dim3(grid), dim3(NTHR), LDS_BYTES, stream, a); }
    const hipError_t le = hipPeekAtLastError();
    if (le != hipSuccess) fprintf(stderr, "kernel_launch: launch failed: %s\n", hipGetErrorName(le));
}
```
